# Optimizing an MI355X kernel written in HIP

```python
import math
import jax, jax.numpy as jnp
from jax import lax
import numpy as np

D_MODEL = 1024
BATCH = 2
SEQ = 8192
DEPTH = 1

RET_HEADS = 8
RET_HEAD_DIM = 128
RET_WIDTH = RET_HEADS * RET_HEAD_DIM
RET_CHUNK = 128
ROPE_BASE = 10000.0
GN_EPS = 1e-5
POOL_WINDOWS = (2, 4, 8, 16)
POOL_GROUPS = len(POOL_WINDOWS)
POOL_WIDTH = D_MODEL
POOL_GROUP = POOL_WIDTH // POOL_GROUPS
N_BRANCHES = 2
IN_WIDTH = 4 * RET_WIDTH + POOL_WIDTH + N_BRANCHES * D_MODEL
N_EXPERTS = 32
TOP_K = 4
D_FF = D_MODEL
SWIGLU_ALPHA = 1.702
SWIGLU_LIMIT = 7.0
EXPERT_BLOCK = 128
PLE_DIM = 256
RMS_EPS = 1e-6

kernel_name = "hybrid_retention_pool_moe_block"


def rms_norm(x, g):
    xf = x.astype(jnp.float32)
    y = xf * lax.rsqrt(jnp.mean(xf * xf, axis=-1, keepdims=True) + RMS_EPS)
    return (y * g.astype(jnp.float32)).astype(x.dtype)


def rotary(x, positions):
    half = x.shape[-1] // 2
    inv = ROPE_BASE ** (-jnp.arange(half, dtype=jnp.float32) / half)
    ang = positions.astype(jnp.float32)[..., None] * inv
    cos = jnp.cos(ang)[:, :, None, :]
    sin = jnp.sin(ang)[:, :, None, :]
    xf = x.astype(jnp.float32)
    x1, x2 = xf[..., :half], xf[..., half:]
    return jnp.concatenate([x1 * cos - x2 * sin, x2 * cos + x1 * sin], axis=-1)


def retention_chunkwise(q, k, v):
    B, S, H, Dh = q.shape
    N = S // RET_CHUNK
    log_gamma = jnp.log1p(-jnp.exp2(-5.0 - jnp.arange(H, dtype=jnp.float32)))
    qc = q.reshape(B, N, RET_CHUNK, H, Dh)
    kc = k.reshape(B, N, RET_CHUNK, H, Dh)
    vc = v.reshape(B, N, RET_CHUNK, H, Dh)
    idx = jnp.arange(RET_CHUNK, dtype=jnp.float32)
    diff = idx[:, None] - idx[None, :]
    causal = diff >= 0
    dmat = jnp.where(causal[None], jnp.exp(log_gamma[:, None, None] * jnp.where(causal, diff, 0.0)[None]), 0.0)
    scores = jnp.einsum('bnihd,bnjhd->bnhij', qc, kc) * dmat
    inner = jnp.einsum('bnhij,bnjhe->bnihe', scores, vc)
    zeta = jnp.exp(log_gamma[:, None] * (RET_CHUNK - 1.0 - idx)[None])
    kv = jnp.einsum('bnjhd,hj,bnjhe->nbhde', kc, zeta, vc)
    chunk_decay = jnp.exp(log_gamma * RET_CHUNK)[None, :, None, None]

    def step(state, kv_n):
        return state * chunk_decay + kv_n, state

    _, prev = lax.scan(step, jnp.zeros((B, H, Dh, Dh), q.dtype), kv)
    xi = jnp.exp(log_gamma[:, None] * (idx + 1.0)[None])
    cross = jnp.einsum('bnihd,nbhde,hi->bnihe', qc, prev, xi)
    return (inner + cross).reshape(B, S, H, Dh)


def pool_mixer(u, w_pool, pool_scale):
    B, S, C = u.shape
    uf = u.astype(jnp.float32)
    csum = jnp.cumsum(uf, axis=1)
    pos = jnp.arange(S)
    outs = []
    for gi, w in enumerate(POOL_WINDOWS):
        sl = slice(gi * POOL_GROUP, (gi + 1) * POOL_GROUP)
        c = csum[..., sl]
        lagged = jnp.pad(c, ((0, 0), (w, 0), (0, 0)))[:, :S]
        count = jnp.minimum(pos + 1, w).astype(jnp.float32)[None, :, None]
        mixed = ((c - lagged) / count - uf[..., sl]).astype(u.dtype)
        outs.append(jnp.einsum('bsc,cd->bsd', mixed, w_pool[gi]))
    return jnp.concatenate(outs, axis=-1) * pool_scale


def swiglu_clamped(gu):
    gate, up = gu[..., :D_FF], gu[..., D_FF:]
    gate = jnp.minimum(gate, SWIGLU_LIMIT)
    up = jnp.clip(up, -SWIGLU_LIMIT, SWIGLU_LIMIT)
    return (up + 1.0) * (gate * jax.nn.sigmoid(gate * SWIGLU_ALPHA))


def moe(h, w_router, b_router, w_gate_up, b_gate_up, w_down, b_down):
    B, S, D = h.shape
    T = B * S
    A = T * TOP_K
    xt = h.reshape(T, D)
    logits = (xt @ w_router + b_router).astype(jnp.float32)
    top_val, top_idx = lax.top_k(logits, TOP_K)
    top_w = jax.nn.softmax(top_val, axis=-1)
    flat_e = top_idx.reshape(A)
    flat_tok = (jnp.arange(A, dtype=jnp.int32) // TOP_K)
    flat_w = top_w.reshape(A)
    order = jnp.argsort(flat_e)
    sorted_e = flat_e[order]
    counts = jnp.bincount(flat_e, length=N_EXPERTS)
    padded = (counts + EXPERT_BLOCK - 1) // EXPERT_BLOCK * EXPERT_BLOCK
    starts = jnp.cumsum(counts) - counts
    pends = jnp.cumsum(padded)
    pstarts = pends - padded
    rank = jnp.arange(A, dtype=jnp.int32) - starts[sorted_e]
    dest = pstarts[sorted_e] + rank
    n_blocks = (A + EXPERT_BLOCK - 1) // EXPERT_BLOCK + N_EXPERTS
    P = n_blocks * EXPERT_BLOCK
    slot_tok = jnp.full((P,), T, jnp.int32).at[dest].set(flat_tok[order])
    slot_w = jnp.zeros((P,), jnp.float32).at[dest].set(flat_w[order])
    block_e = jnp.clip(jnp.searchsorted(pends, jnp.arange(n_blocks) * EXPERT_BLOCK, side='right'), 0, N_EXPERTS - 1)
    x_pad = jnp.concatenate([xt, jnp.zeros((1, D), xt.dtype)], axis=0)
    xb = x_pad[slot_tok].reshape(n_blocks, EXPERT_BLOCK, D)

    def expert_block(args):
        xblk, e = args
        act = swiglu_clamped(xblk @ w_gate_up[e] + b_gate_up[e])
        return act @ w_down[e] + b_down[e]

    yb = lax.map(expert_block, (xb, block_e)).reshape(P, D)
    yb = yb * slot_w[:, None].astype(yb.dtype)
    y = jnp.zeros((T + 1, D), yb.dtype).at[slot_tok].add(yb)[:T]
    return y.reshape(B, S, D)


def setup_inputs(seed: int = 0) -> dict:
    key = jax.random.key(seed)
    ks = jax.random.split(key, 24)
    f32 = jnp.float32
    nrm = lambda k, shape, scale: jax.random.normal(k, shape, f32) * scale
    L = DEPTH
    return {
        "x": nrm(ks[0], (BATCH, SEQ, D_MODEL), 1.0),
        "p": nrm(ks[1], (DEPTH, BATCH, SEQ, PLE_DIM), 1.0),
        "positions": jnp.broadcast_to(jnp.arange(SEQ, dtype=jnp.int32)[None], (BATCH, SEQ)),
        "g_mix_norm": 1.0 + nrm(ks[2], (L, D_MODEL), 0.05),
        "w_in": nrm(ks[3], (L, D_MODEL, IN_WIDTH), D_MODEL ** -0.5),
        "g_ret_norm": 1.0 + nrm(ks[4], (L, RET_WIDTH), 0.05),
        "w_pool": nrm(ks[5], (L, POOL_GROUPS, POOL_GROUP, POOL_GROUP), POOL_GROUP ** -0.5),
        "pool_scale": 1.0 + nrm(ks[6], (L, POOL_WIDTH), 0.05),
        "w_branch": nrm(ks[7], (L, N_BRANCHES, RET_WIDTH, D_MODEL), RET_WIDTH ** -0.5),
        "w_out": nrm(ks[8], (L, D_MODEL, D_MODEL), D_MODEL ** -0.5),
        "g_ffn_norm": 1.0 + nrm(ks[9], (L, D_MODEL), 0.05),
        "w_router": nrm(ks[10], (L, D_MODEL, N_EXPERTS), D_MODEL ** -0.5),
        "b_router": nrm(ks[11], (L, N_EXPERTS), 0.01),
        "w_gate_up": nrm(ks[12], (L, N_EXPERTS, D_MODEL, 2 * D_FF), D_MODEL ** -0.5),
        "b_gate_up": nrm(ks[13], (L, N_EXPERTS, 2 * D_FF), 0.01),
        "w_down": nrm(ks[14], (L, N_EXPERTS, D_FF, D_MODEL), D_FF ** -0.5),
        "b_down": nrm(ks[15], (L, N_EXPERTS, D_MODEL), 0.01),
        "g_ple_norm": 1.0 + nrm(ks[16], (L, D_MODEL), 0.05),
        "w_ple_gate": nrm(ks[17], (L, D_MODEL, D_MODEL), D_MODEL ** -0.5),
        "w_ple_proj": nrm(ks[18], (L, PLE_DIM, D_MODEL), PLE_DIM ** -0.5),
        "g_final": 1.0 + nrm(ks[19], (D_MODEL,), 0.05),
    }


def reference(x, p, positions, g_mix_norm, w_in, g_ret_norm, w_pool, pool_scale, w_branch, w_out,
              g_ffn_norm, w_router, b_router, w_gate_up, b_gate_up, w_down, b_down,
              g_ple_norm, w_ple_gate, w_ple_proj, g_final):
    B, S, D = x.shape
    for i in range(DEPTH):
        h = rms_norm(x, g_mix_norm[i])
        proj = h @ w_in[i]
        q, k, v, g_ret, u_pool, gate_a, gate_b = jnp.split(
            proj, np.cumsum([RET_WIDTH] * 4 + [POOL_WIDTH, D_MODEL]).tolist(), axis=-1)
        qh = rotary(q.reshape(B, S, RET_HEADS, RET_HEAD_DIM), positions)
        kh = rotary(k.reshape(B, S, RET_HEADS, RET_HEAD_DIM), positions) * (RET_HEAD_DIM ** -0.5)
        vh = v.reshape(B, S, RET_HEADS, RET_HEAD_DIM).astype(jnp.float32)
        ret = retention_chunkwise(qh, kh, vh)
        mu = jnp.mean(ret, axis=-1, keepdims=True)
        var = jnp.mean(jnp.square(ret - mu), axis=-1, keepdims=True)
        ret = ((ret - mu) * lax.rsqrt(var + GN_EPS)).reshape(B, S, RET_WIDTH)
        ret = (ret * g_ret_norm[i].astype(jnp.float32)).astype(x.dtype)
        y_ret = jax.nn.silu(g_ret) * ret
        y_pool = pool_mixer(u_pool, w_pool[i], pool_scale[i])
        branch_a = y_ret @ w_branch[i, 0]
        branch_b = y_pool @ w_branch[i, 1]
        merged = jax.nn.sigmoid(gate_a) * branch_a + jax.nn.sigmoid(gate_b) * branch_b
        x = x + merged @ w_out[i]
        h2 = rms_norm(x, g_ffn_norm[i])
        x = x + moe(h2, w_router[i], b_router[i], w_gate_up[i], b_gate_up[i], w_down[i], b_down[i])
        h3 = rms_norm(x, g_ple_norm[i])
        ple_gate = jax.nn.sigmoid(h3 @ w_ple_gate[i])
        x = x + ple_gate * (p[i].astype(x.dtype) @ w_ple_proj[i])
    return rms_norm(x, g_final)
```

```cpp
#include <hip/hip_runtime.h>
#include <cstdio>
#include <cstdint>
#include <cstring>

constexpr int DM = 1024, NB = 2, SEQ = 8192, NT = NB * SEQ;
constexpr int NH = 8, DH = 128, CH = 128, NCH = SEQ / CH;
constexpr int INW = 7168;
constexpr int NE = 32, TOPK = 4, DFF = 1024;
constexpr int PLE = 256;
constexpr float RMS_EPS = 1e-6f, GN_EPS = 1e-5f;
constexpr float SW_ALPHA = 1.702f, SW_LIMIT = 7.0f;

constexpr size_t MiB = 1u << 20;
constexpr size_t WS_CTL = 0, CTL_ZERO_BYTES = 1 * MiB;
constexpr size_t WS_TOPE = 1 * MiB, WS_TOPW = WS_TOPE + 256 * 1024, WS_ROWLIST = 2 * MiB, WS_ROWW = 4 * MiB;
constexpr size_t WS_TRIG = 8 * MiB;
constexpr size_t WS_WIN = 16 * MiB, WS_WB = 30 * MiB, WS_WOUT = 34 * MiB, WS_WPG = 36 * MiB, WS_WPP = 38 * MiB;
constexpr size_t WS_WGU = 40 * MiB, WS_WD = 168 * MiB;
constexpr size_t WS_H = 232 * MiB, WS_PB = 264 * MiB, WS_PP = 272 * MiB;
constexpr size_t WS_Q = 304 * MiB, WS_K = 336 * MiB, WS_V = 368 * MiB, WS_SG = 400 * MiB, WS_U = 432 * MiB, WS_GA = 464 * MiB, WS_GB = 496 * MiB;
constexpr size_t WS_KVT = 528 * MiB, WS_PREVT = 592 * MiB, WS_YM = 624 * MiB, WS_MERGED = 688 * MiB;
constexpr size_t WS_X1 = 720 * MiB, WS_H2 = 784 * MiB, WS_X2 = 816 * MiB, WS_H3 = 880 * MiB, WS_END = 912 * MiB;
constexpr size_t WS_ACT = WS_Q;
constexpr size_t WS_OUT4 = WS_GA;
constexpr size_t WS_TMPA = WS_X1, WS_TMPB = WS_X2;
constexpr int CW_CNT = 1024;

typedef unsigned short bf16;
typedef float f32x4 __attribute__((ext_vector_type(4)));
typedef unsigned u32x4 __attribute__((ext_vector_type(4)));
typedef unsigned u32x2 __attribute__((ext_vector_type(2)));

__device__ __forceinline__ unsigned f2bf(float f) { unsigned u = __builtin_bit_cast(unsigned, f); return (u + 0x7fffu + ((u >> 16) & 1u)) >> 16; }
__device__ __forceinline__ float bf2f(unsigned b) { return __builtin_bit_cast(float, (b & 0xffffu) << 16); }
__device__ __forceinline__ float wave_sum(float v) {
#pragma unroll
    for (int o = 1; o < 64; o <<= 1) v += __shfl_xor(v, o);
    return v;
}
__device__ __forceinline__ float sigmoidf_(float x) { return 1.0f / (1.0f + __expf(-x)); }
__device__ __forceinline__ float log_gamma_h(int h) { return log1pf(-exp2f(-5.0f - (float)h)); }

__device__ __forceinline__ void rot_cs(int pos, int d, float& c, float& s) {
    const double inv = exp2(-(double)d * (13.287712379549449 / 64.0));
    const double a = (double)pos * inv;
    const double n = rint(a * 0.15915494309189535);
    const double r = fma(-n, 6.283185307179586, a) - n * 2.4492935982947064e-16;
    c = (float)cos(r); s = (float)sin(r);
}

#ifndef MK_NAIVE
#define MK_NAIVE 1
#endif

#if MK_NAIVE
namespace nv {
__global__ void __launch_bounds__(256) rmsnorm_rows(const float* x, const float* g, bf16* ob, float* of, int M) {
    const int row = blockIdx.x * 4 + (threadIdx.x >> 6), lane = threadIdx.x & 63; if (row >= M) return;
    const float* xr = x + (size_t)row * DM; float v[16]; float s = 0.f;
#pragma unroll
    for (int j = 0; j < 16; ++j) { v[j] = xr[lane + 64 * j]; s += v[j] * v[j]; }
    const float rs = rsqrtf(wave_sum(s) * (1.0f / DM) + RMS_EPS);
#pragma unroll
    for (int j = 0; j < 16; ++j) { const float o = v[j] * rs * g[lane + 64 * j]; if (ob) ob[(size_t)row * DM + lane + 64 * j] = (bf16)f2bf(o); if (of) of[(size_t)row * DM + lane + 64 * j] = o; }
}
template <typename AT> __device__ __forceinline__ float lda_(const AT* p);
template <> __device__ __forceinline__ float lda_<float>(const float* p) { return *p; }
template <> __device__ __forceinline__ float lda_<bf16>(const bf16* p) { return bf2f(*p); }

template <class Epi> struct GArgs { const void* A; const int* rowmap; const unsigned* cntp; const float* W; unsigned long long wstride; int lda, rowshift, M, ldw, K, pad; Epi epi; };
template <class Epi, typename AT>
__global__ void __launch_bounds__(256) gemm(GArgs<Epi> ga) {
    const AT* A = (const AT*)ga.A; const int lda = ga.lda; const int* rowmap = ga.rowmap; const int rowshift = ga.rowshift; const unsigned* cntp = ga.cntp; const int M = ga.M;
    const float* W = ga.W; const int ldw = ga.ldw; const size_t wstride = ga.wstride; const int K = ga.K; const Epi epi = ga.epi;
    const int z = blockIdx.z; const int Mv = cntp ? (int)cntp[z] : M;
    const int r0 = blockIdx.y * 16; if (r0 >= Mv) return;
    const int p = blockIdx.x * 256 + threadIdx.x; int n0, n1; epi.cols(p, n0, n1);
    const float* Wz = W + (size_t)z * wstride;
    const AT* Ar[16];
#pragma unroll
    for (int r = 0; r < 16; ++r) { int rr = r0 + r; if (rr >= Mv) rr = Mv - 1; const int arow = rowmap ? (rowmap[(size_t)z * NT + rr] >> rowshift) : rr; Ar[r] = A + (size_t)arow * lda; }
    float acc0[16], acc1[16];
#pragma unroll
    for (int r = 0; r < 16; ++r) { acc0[r] = 0.f; acc1[r] = 0.f; }
    for (int k = 0; k < K; ++k) {
        const float b0 = Wz[(size_t)k * ldw + n0]; const float b1 = n1 >= 0 ? Wz[(size_t)k * ldw + n1] : 0.f;
#pragma unroll
        for (int r = 0; r < 16; ++r) { const float a = lda_<AT>(Ar[r] + k); acc0[r] = fmaf(a, b0, acc0[r]); acc1[r] = fmaf(a, b1, acc1[r]); }
    }
#pragma unroll
    for (int r = 0; r < 16; ++r) if (r0 + r < Mv) epi.store(z, r0 + r, p, acc0[r], acc1[r]);
}
struct EpiRot {
    const int* pos; bf16* out; int seg; float scale;
    __device__ void cols(int p, int& n0, int& n1) const { n0 = seg * 1024 + (p >> 6) * 128 + (p & 63); n1 = n0 + 64; }
    __device__ void store(int, int r, int p, float a0, float a1) const {
        float c, s; rot_cs(pos[r], p & 63, c, s);
        const int col = (p >> 6) * 128 + (p & 63);
        out[(size_t)r * DM + col] = (bf16)f2bf((a0 * c - a1 * s) * scale); out[(size_t)r * DM + col + 64] = (bf16)f2bf((a1 * c + a0 * s) * scale);
    }
};
struct EpiAct {
    bf16* out; int seg; int act;
    __device__ void cols(int p, int& n0, int& n1) const { n0 = seg * 1024 + p; n1 = -1; }
    __device__ void store(int, int r, int p, float a0, float) const {
        float v = a0; if (act == 1) v = a0 * sigmoidf_(a0); else if (act == 2) v = sigmoidf_(a0);
        out[(size_t)r * DM + p] = (bf16)f2bf(v);
    }
};
struct EpiGateA {
    const bf16* ga; float* out;
    __device__ void cols(int p, int& n0, int& n1) const { n0 = p; n1 = -1; }
    __device__ void store(int, int r, int p, float a0, float) const { out[(size_t)r * DM + p] = bf2f(ga[(size_t)r * DM + p]) * a0; }
};
struct EpiGateB {
    const bf16* gb; const float* t; bf16* out;
    __device__ void cols(int p, int& n0, int& n1) const { n0 = p; n1 = -1; }
    __device__ void store(int, int r, int p, float a0, float) const { out[(size_t)r * DM + p] = (bf16)f2bf(t[(size_t)r * DM + p] + bf2f(gb[(size_t)r * DM + p]) * a0); }
};
struct EpiResid {
    const float* base; float* out;
    __device__ void cols(int p, int& n0, int& n1) const { n0 = p; n1 = -1; }
    __device__ void store(int, int r, int p, float a0, float) const { out[(size_t)r * DM + p] = base[(size_t)r * DM + p] + a0; }
};
struct EpiBf16 {
    bf16* out; int ld; int pad;
    __device__ void cols(int p, int& n0, int& n1) const { n0 = p; n1 = -1; }
    __device__ void store(int, int r, int p, float a0, float) const { out[(size_t)r * ld + p] = (bf16)f2bf(a0); }
};
__device__ __forceinline__ float swiglu_(float g, float u) {
    g = fminf(g, SW_LIMIT); u = fminf(fmaxf(u, -SW_LIMIT), SW_LIMIT);
    return (u + 1.0f) * (g * sigmoidf_(g * SW_ALPHA));
}
struct EpiSwiglu {
    const float* bias; const unsigned* cnt; bf16* act;
    __device__ void cols(int p, int& n0, int& n1) const { n0 = p; n1 = 1024 + p; }
    __device__ void store(int z, int r, int p, float a0, float a1) const {
        unsigned st = 0; for (int e = 0; e < z; ++e) st += cnt[e];
        act[(size_t)(st + r) * DFF + p] = (bf16)f2bf(swiglu_(a0 + bias[(size_t)z * 2048 + p], a1 + bias[(size_t)z * 2048 + 1024 + p]));
    }
};
struct EpiDown {
    const float* bias; const int* rowlist; const float* roww; bf16* out4;
    __device__ void cols(int p, int& n0, int& n1) const { n0 = p; n1 = -1; }
    __device__ void store(int z, int r, int p, float a0, float) const {
        const int ent = rowlist[(size_t)z * NT + r]; const float w = roww[(size_t)z * NT + r];
        out4[(size_t)ent * DM + p] = (bf16)f2bf(w * (a0 + bias[(size_t)z * DM + p]));
    }
};
struct EpiPle {
    const float* x2; const bf16* pp; float* out;
    __device__ void cols(int p, int& n0, int& n1) const { n0 = p; n1 = -1; }
    __device__ void store(int, int r, int p, float a0, float) const { out[(size_t)r * DM + p] = x2[(size_t)r * DM + p] + sigmoidf_(a0) * bf2f(pp[(size_t)r * DM + p]); }
};
template <class Epi>
__global__ void __launch_bounds__(256) gemm_down(const bf16* act, const unsigned* cnt, const float* W, Epi epi) {
    const int z = blockIdx.z; const int Mv = (int)cnt[z];
    const int r0 = blockIdx.y * 16; if (r0 >= Mv) return;
    unsigned st = 0; for (int e = 0; e < z; ++e) st += cnt[e];
    const int p = blockIdx.x * 256 + threadIdx.x;
    const float* Wz = W + (size_t)z * DFF * DM;
    const bf16* Ar[16];
#pragma unroll
    for (int r = 0; r < 16; ++r) { int rr = r0 + r; if (rr >= Mv) rr = Mv - 1; Ar[r] = act + (size_t)(st + rr) * DFF; }
    float acc0[16];
#pragma unroll
    for (int r = 0; r < 16; ++r) acc0[r] = 0.f;
    for (int k = 0; k < DFF; ++k) {
        const float b0 = Wz[(size_t)k * DM + p];
#pragma unroll
        for (int r = 0; r < 16; ++r) acc0[r] = fmaf(bf2f(Ar[r][k]), b0, acc0[r]);
    }
#pragma unroll
    for (int r = 0; r < 16; ++r) if (r0 + r < Mv) epi.store(z, r0 + r, p, acc0[r], 0.f);
}

__global__ void __launch_bounds__(256) ret_kv(const bf16* K, const bf16* V, float* kvt) {
    const int n = blockIdx.x, bh = blockIdx.y, b = bh / NH, h = bh % NH; const float lg = log_gamma_h(h);
    const size_t row0 = (size_t)b * SEQ + (size_t)n * CH;
    __shared__ float sk[CH][DH + 1]; __shared__ float sv[CH][DH + 1];
    for (int i = threadIdx.x; i < CH * DH; i += 256) { const int j = i >> 7, c = i & 127; const float z = __expf(lg * (float)(CH - 1 - j));
        sk[j][c] = bf2f(K[(row0 + j) * DM + h * DH + c]); sv[j][c] = z * bf2f(V[(row0 + j) * DM + h * DH + c]); }
    __syncthreads();
    float* o = kvt + ((size_t)bh * NCH + n) * DH * DH;
    for (int i = threadIdx.x; i < DH * DH; i += 256) { const int e = i >> 7, d = i & 127; float a = 0.f;
        for (int j = 0; j < CH; ++j) a = fmaf(sk[j][d], sv[j][e], a);
        o[(size_t)e * DH + d] = a; }
}
__global__ void __launch_bounds__(256) ret_scan(const float* kvt, bf16* prevt) {
    const int idx = blockIdx.x * 256 + threadIdx.x; const int bh = idx / (DH * DH), ed = idx % (DH * DH); const int h = bh % NH;
    const float dec = __expf(log_gamma_h(h) * (float)CH); float st = 0.f;
    for (int n = 0; n < NCH; ++n) { const size_t o = ((size_t)bh * NCH + n) * DH * DH + ed; prevt[o] = (bf16)f2bf(st); st = st * dec + kvt[o]; }
}
__global__ void __launch_bounds__(128) ret_out(const bf16* Q, const bf16* K, const bf16* V, const bf16* prevt, const bf16* SG, const float* gn, bf16* YM) {
    const int t = blockIdx.x, h = blockIdx.y, b = t / SEQ, tt = t % SEQ, n = tt / CH, i = tt % CH, e = threadIdx.x; const float lg = log_gamma_h(h);
    __shared__ float sq[DH]; __shared__ float ss[CH]; __shared__ float red[4];
    sq[e] = bf2f(Q[(size_t)t * DM + h * DH + e]);
    __syncthreads();
    { const int j = e; float a = 0.f; if (j <= i) { const bf16* kr = K + ((size_t)b * SEQ + (size_t)n * CH + j) * DM + h * DH; for (int d = 0; d < DH; ++d) a = fmaf(sq[d], bf2f(kr[d]), a); a *= __expf(lg * (float)(i - j)); } ss[j] = a; }
    __syncthreads();
    float inner = 0.f; for (int j = 0; j <= i; ++j) inner = fmaf(ss[j], bf2f(V[((size_t)b * SEQ + (size_t)n * CH + j) * DM + h * DH + e]), inner);
    const bf16* pt = prevt + (((size_t)(b * NH + h)) * NCH + n) * DH * DH + (size_t)e * DH; float cr = 0.f;
    for (int d = 0; d < DH; ++d) cr = fmaf(sq[d], bf2f(pt[d]), cr);
    const float r = inner + __expf(lg * (float)(i + 1)) * cr;
    float s1 = wave_sum(r); if ((e & 63) == 0) red[e >> 6] = s1; __syncthreads(); const float mu = (red[0] + red[1]) * (1.0f / DH);
    const float dv = r - mu; float s2 = wave_sum(dv * dv); if ((e & 63) == 0) red[2 + (e >> 6)] = s2; __syncthreads(); const float var = (red[2] + red[3]) * (1.0f / DH);
    const float y = dv * rsqrtf(var + GN_EPS) * gn[h * DH + e];
    const float yb = bf2f(f2bf(y));
    (void)yb;
    YM[(size_t)t * 2048 + h * DH + e] = (bf16)f2bf(bf2f(SG[(size_t)t * DM + h * DH + e]) * y);
}
__global__ void __launch_bounds__(256) pool_mixed(const bf16* U, bf16* YM) {
    const size_t idx = (size_t)blockIdx.x * 256 + threadIdx.x; const int t = (int)(idx >> 10), c = (int)(idx & 1023); const int tt = t % SEQ; const int w = 2 << (c >> 8);
    const int cnt = tt + 1 < w ? tt + 1 : w; float s = 0.f;
    for (int k = 0; k < cnt; ++k) s += bf2f(U[(size_t)(t - k) * DM + c]);
    YM[(size_t)t * 2048 + 1024 + c] = (bf16)f2bf(s / (float)cnt - bf2f(U[(size_t)t * DM + c]));
}
__global__ void __launch_bounds__(256) pool_proj(const bf16* YM, const float* wp, const float* scale, float* out) {
    const int g = blockIdx.x, r0 = blockIdx.y * 16, dd = threadIdx.x; float acc[16];
#pragma unroll
    for (int r = 0; r < 16; ++r) acc[r] = 0.f;
    for (int c = 0; c < 256; ++c) { const float w = wp[((size_t)g * 256 + c) * 256 + dd];
#pragma unroll
        for (int r = 0; r < 16; ++r) acc[r] = fmaf(bf2f(YM[(size_t)(r0 + r) * 2048 + 1024 + g * 256 + c]), w, acc[r]); }
#pragma unroll
    for (int r = 0; r < 16; ++r) out[(size_t)(r0 + r) * DM + g * 256 + dd] = acc[r] * scale[g * 256 + dd];
}
__global__ void __launch_bounds__(256) router(const float* x1, const float* g, const float* wr, const float* br, bf16* h2, int* tope, float* topw) {
    const int t = blockIdx.x * 4 + (threadIdx.x >> 6), lane = threadIdx.x & 63;
    const float* xr = x1 + (size_t)t * DM; float v[16]; float s = 0.f;
#pragma unroll
    for (int j = 0; j < 16; ++j) { v[j] = xr[lane + 64 * j]; s += v[j] * v[j]; }
    const float rs = rsqrtf(wave_sum(s) * (1.0f / DM) + RMS_EPS);
#pragma unroll
    for (int j = 0; j < 16; ++j) { v[j] = v[j] * rs * g[lane + 64 * j]; h2[(size_t)t * DM + lane + 64 * j] = (bf16)f2bf(v[j]); }
    const int e = lane & 31; float lg = 0.f;
#pragma unroll
    for (int j = 0; j < 16; ++j)
        for (int l = 0; l < 64; ++l) { const float hv = __shfl(v[j], l); lg = fmaf(hv, wr[(size_t)(l + 64 * j) * NE + e], lg); }
    lg += br[e];
    float val = lg; int sel[4]; float sv[4];
#pragma unroll
    for (int k = 0; k < 4; ++k) {
        float m = val; int mi = e;
#pragma unroll
        for (int o = 1; o < 32; o <<= 1) { const float om = __shfl_xor(m, o); const int oi = __shfl_xor(mi, o); if (om > m || (om == m && oi < mi)) { m = om; mi = oi; } }
        sel[k] = mi; sv[k] = m; if (e == mi) val = -INFINITY;
    }
    const float e0 = 1.f, e1 = __expf(sv[1] - sv[0]), e2 = __expf(sv[2] - sv[0]), e3 = __expf(sv[3] - sv[0]); const float inv = 1.f / (e0 + e1 + e2 + e3);
    if (lane == 0) { tope[t * 4 + 0] = sel[0]; tope[t * 4 + 1] = sel[1]; tope[t * 4 + 2] = sel[2]; tope[t * 4 + 3] = sel[3];
        topw[t * 4 + 0] = e0 * inv; topw[t * 4 + 1] = e1 * inv; topw[t * 4 + 2] = e2 * inv; topw[t * 4 + 3] = e3 * inv; }
}
__global__ void __launch_bounds__(64) build_lists(const int* tope, const float* topw, int* rowlist, float* roww, unsigned* cnt) {
    const int e = blockIdx.x, lane = threadIdx.x; unsigned base = 0;
    for (int a0 = 0; a0 < NT * TOPK; a0 += 64) { const int a = a0 + lane; const bool hit = tope[a] == e;
        const unsigned long long m = __ballot(hit); const unsigned before = __popcll(m & ((1ull << lane) - 1ull));
        if (hit) { rowlist[(size_t)e * NT + base + before] = a; roww[(size_t)e * NT + base + before] = topw[a]; }
        base += __popcll(m); }
    if (lane == 0) cnt[e] = base;
}
__global__ void __launch_bounds__(256) combine(const float* x1, const bf16* out4, const float* g, float* x2, bf16* h3) {
    const int t = blockIdx.x * 4 + (threadIdx.x >> 6), lane = threadIdx.x & 63; float v[16]; float s = 0.f;
#pragma unroll
    for (int j = 0; j < 16; ++j) { const int c = lane + 64 * j; float a = x1[(size_t)t * DM + c];
        for (int k = 0; k < 4; ++k) a += bf2f(out4[((size_t)t * 4 + k) * DM + c]);
        v[j] = a; s += a * a; x2[(size_t)t * DM + c] = a; }
    const float rs = rsqrtf(wave_sum(s) * (1.0f / DM) + RMS_EPS);
#pragma unroll
    for (int j = 0; j < 16; ++j) h3[(size_t)t * DM + lane + 64 * j] = (bf16)f2bf(v[j] * rs * g[lane + 64 * j]);
}
__global__ void __launch_bounds__(256) final_norm(float* out, const float* g) {
    const int row = blockIdx.x * 4 + (threadIdx.x >> 6), lane = threadIdx.x & 63; float* xr = out + (size_t)row * DM; float v[16]; float s = 0.f;
#pragma unroll
    for (int j = 0; j < 16; ++j) { v[j] = xr[lane + 64 * j]; s += v[j] * v[j]; }
    const float rs = rsqrtf(wave_sum(s) * (1.0f / DM) + RMS_EPS);
#pragma unroll
    for (int j = 0; j < 16; ++j) xr[lane + 64 * j] = v[j] * rs * g[lane + 64 * j];
}
}

template <class Epi, typename AT>
static void launch_gemm(hipStream_t st, dim3 grid, const AT* A, int lda, const int* rowmap, int rowshift, const unsigned* cntp, int M, const float* W, int ldw, size_t wstride, int K, const Epi& epi) {
    nv::GArgs<Epi> a; memset(&a, 0, sizeof(a));
    a.A = A; a.rowmap = rowmap; a.cntp = cntp; a.W = W; a.wstride = wstride; a.lda = lda; a.rowshift = rowshift; a.M = M; a.ldw = ldw; a.K = K; a.epi = epi;
    nv::gemm<Epi, AT><<<grid, 256, 0, st>>>(a);
}
static void naive_forward(void* const* d_in, float* out, unsigned char* ws, hipStream_t st) {
    const float* x = (const float*)d_in[0]; const float* p = (const float*)d_in[1]; const int* pos = (const int*)d_in[2];
    const float* g_mix = (const float*)d_in[3]; const float* w_in = (const float*)d_in[4]; const float* g_ret = (const float*)d_in[5];
    const float* w_pool = (const float*)d_in[6]; const float* pool_scale = (const float*)d_in[7]; const float* w_branch = (const float*)d_in[8];
    const float* w_out = (const float*)d_in[9]; const float* g_ffn = (const float*)d_in[10]; const float* w_router = (const float*)d_in[11];
    const float* b_router = (const float*)d_in[12]; const float* w_gu = (const float*)d_in[13]; const float* b_gu = (const float*)d_in[14];
    const float* w_down = (const float*)d_in[15]; const float* b_down = (const float*)d_in[16]; const float* g_ple = (const float*)d_in[17];
    const float* w_pg = (const float*)d_in[18]; const float* w_pp = (const float*)d_in[19]; const float* g_final = (const float*)d_in[20];
    bf16* H = (bf16*)(ws + WS_H); bf16* Q = (bf16*)(ws + WS_Q); bf16* K = (bf16*)(ws + WS_K); bf16* V = (bf16*)(ws + WS_V);
    bf16* SG = (bf16*)(ws + WS_SG); bf16* U = (bf16*)(ws + WS_U); bf16* GA = (bf16*)(ws + WS_GA); bf16* GB = (bf16*)(ws + WS_GB);
    float* KVT = (float*)(ws + WS_KVT); bf16* PREVT = (bf16*)(ws + WS_PREVT); bf16* YM = (bf16*)(ws + WS_YM); bf16* MERGED = (bf16*)(ws + WS_MERGED);
    float* X1 = (float*)(ws + WS_X1); bf16* H2 = (bf16*)(ws + WS_H2); float* X2 = (float*)(ws + WS_X2); bf16* H3 = (bf16*)(ws + WS_H3);
    bf16* ACT = (bf16*)(ws + WS_ACT); bf16* OUT4 = (bf16*)(ws + WS_OUT4); bf16* PP = (bf16*)(ws + WS_PP);
    float* TMPA = (float*)(ws + WS_TMPA); float* TMPB = (float*)(ws + WS_TMPB);
    int* TOPE = (int*)(ws + WS_TOPE); float* TOPW = (float*)(ws + WS_TOPW); int* ROWLIST = (int*)(ws + WS_ROWLIST); float* ROWW = (float*)(ws + WS_ROWW);
    unsigned* CNT = (unsigned*)(ws + WS_CTL) + CW_CNT;
    nv::rmsnorm_rows<<<NT / 4, 256, 0, st>>>(x, g_mix, H, nullptr, NT);
    launch_gemm<nv::EpiRot, bf16>(st, dim3(2, NT / 16, 1), H, DM, nullptr, 0, nullptr, NT, w_in, INW, 0, DM, nv::EpiRot{pos, Q, 0, 1.0f});
    launch_gemm<nv::EpiRot, bf16>(st, dim3(2, NT / 16, 1), H, DM, nullptr, 0, nullptr, NT, w_in, INW, 0, DM, nv::EpiRot{pos, K, 1, 0.08838834764831845f});
    launch_gemm<nv::EpiAct, bf16>(st, dim3(4, NT / 16, 1), H, DM, nullptr, 0, nullptr, NT, w_in, INW, 0, DM, nv::EpiAct{V, 2, 0});
    launch_gemm<nv::EpiAct, bf16>(st, dim3(4, NT / 16, 1), H, DM, nullptr, 0, nullptr, NT, w_in, INW, 0, DM, nv::EpiAct{SG, 3, 1});
    launch_gemm<nv::EpiAct, bf16>(st, dim3(4, NT / 16, 1), H, DM, nullptr, 0, nullptr, NT, w_in, INW, 0, DM, nv::EpiAct{U, 4, 0});
    launch_gemm<nv::EpiAct, bf16>(st, dim3(4, NT / 16, 1), H, DM, nullptr, 0, nullptr, NT, w_in, INW, 0, DM, nv::EpiAct{GA, 5, 2});
    launch_gemm<nv::EpiAct, bf16>(st, dim3(4, NT / 16, 1), H, DM, nullptr, 0, nullptr, NT, w_in, INW, 0, DM, nv::EpiAct{GB, 6, 2});
    nv::ret_kv<<<dim3(NCH, NB * NH), 256, 0, st>>>(K, V, KVT);
    nv::ret_scan<<<NB * NH * DH * DH / 256, 256, 0, st>>>(KVT, PREVT);
    nv::ret_out<<<dim3(NT, NH), 128, 0, st>>>(Q, K, V, PREVT, SG, g_ret, YM);
    nv::pool_mixed<<<NT * DM / 256, 256, 0, st>>>(U, YM);
    nv::pool_proj<<<dim3(4, NT / 16), 256, 0, st>>>(YM, w_pool, pool_scale, TMPA);
    launch_gemm<nv::EpiGateA, bf16>(st, dim3(4, NT / 16, 1), YM, 2048, nullptr, 0, nullptr, NT, w_branch, DM, 0, DM, nv::EpiGateA{GA, TMPB});
    launch_gemm<nv::EpiGateB, float>(st, dim3(4, NT / 16, 1), TMPA, DM, nullptr, 0, nullptr, NT, w_branch + (size_t)DM * DM, DM, 0, DM, nv::EpiGateB{GB, TMPB, MERGED});
    launch_gemm<nv::EpiResid, bf16>(st, dim3(4, NT / 16, 1), MERGED, DM, nullptr, 0, nullptr, NT, w_out, DM, 0, DM, nv::EpiResid{x, X1});
    nv::router<<<NT / 4, 256, 0, st>>>(X1, g_ffn, w_router, b_router, H2, TOPE, TOPW);
    nv::build_lists<<<NE, 64, 0, st>>>(TOPE, TOPW, ROWLIST, ROWW, CNT);
    launch_gemm<nv::EpiSwiglu, bf16>(st, dim3(4, NT / 16, NE), H2, DM, ROWLIST, 2, CNT, NT, w_gu, 2048, (size_t)DM * 2048, DM, nv::EpiSwiglu{b_gu, CNT, ACT});
    nv::gemm_down<nv::EpiDown><<<dim3(4, NT / 16, NE), 256, 0, st>>>(ACT, CNT, w_down, nv::EpiDown{b_down, ROWLIST, ROWW, OUT4});
    nv::combine<<<NT / 4, 256, 0, st>>>(X1, OUT4, g_ple, X2, H3);
    launch_gemm<nv::EpiBf16, float>(st, dim3(4, NT / 16, 1), p, PLE, nullptr, 0, nullptr, NT, w_pp, DM, 0, PLE, nv::EpiBf16{PP, DM, 0});
    launch_gemm<nv::EpiPle, bf16>(st, dim3(4, NT / 16, 1), H3, DM, nullptr, 0, nullptr, NT, w_pg, DM, 0, DM, nv::EpiPle{X2, PP, out});
    nv::final_norm<<<NT / 4, 256, 0, st>>>(out, g_final);
}
#endif

extern "C" void kernel_launch(void* const* d_in, const int* in_sizes, int n_in, void* d_out, int out_size, void* d_ws, size_t ws_size, hipStream_t stream) {
    if (n_in != 21 || out_size != NT * DM || ws_size < WS_END) { fprintf(stderr, "kernel_launch: unexpected shapes (n_in %d out %d ws %zu)\n", n_in, out_size, ws_size); return; }
    (void)in_sizes;
    (void)hipMemsetAsync((char*)d_ws + WS_CTL, 0, CTL_ZERO_BYTES, stream);
#if MK_NAIVE
    naive_forward(d_in, (float*)d_out, (unsigned char*)d_ws, stream);
#endif
}
```

```cpp
#include <hip/hip_runtime.h>
#include <cstdio>
#include <cstdint>
#include <cstring>

constexpr int DM = 1024, NB = 2, SEQ = 8192, NT = NB * SEQ;
constexpr int NH = 8, DH = 128, CH = 128, NCH = SEQ / CH;
constexpr int INW = 7168;
constexpr int NE = 32, TOPK = 4, DFF = 1024;
constexpr int PLE = 256;
constexpr float RMS_EPS = 1e-6f, GN_EPS = 1e-5f;
constexpr float SW_ALPHA = 1.702f, SW_LIMIT = 7.0f;

constexpr size_t MiB = 1u << 20;
constexpr size_t WS_CTL = 0, CTL_ZERO_BYTES = 1 * MiB;
constexpr size_t WS_TOPE = 1 * MiB, WS_TOPW = WS_TOPE + 256 * 1024, WS_ROWLIST = 2 * MiB, WS_ROWW = 4 * MiB;
constexpr size_t WS_TRIG = 8 * MiB;
constexpr size_t WS_WIN = 16 * MiB, WS_WB = 30 * MiB, WS_WOUT = 34 * MiB, WS_WPG = 36 * MiB, WS_WPP = 38 * MiB;
constexpr size_t WS_WRG = 39 * MiB;
constexpr size_t WS_WGU = 40 * MiB, WS_WD = 168 * MiB;
constexpr size_t WS_H = 232 * MiB, WS_PB = 264 * MiB, WS_PP = 272 * MiB;
constexpr size_t WS_Q = 304 * MiB, WS_K = 336 * MiB, WS_V = 368 * MiB, WS_SG = 400 * MiB, WS_U = 432 * MiB, WS_GA = 464 * MiB, WS_GB = 496 * MiB;
constexpr size_t WS_KVT = 528 * MiB, WS_PREVT = 592 * MiB, WS_YM = 624 * MiB, WS_MERGED = 688 * MiB;
constexpr size_t WS_X1 = 720 * MiB, WS_H2 = 784 * MiB, WS_X2 = 816 * MiB, WS_H3 = 880 * MiB, WS_END = 912 * MiB;
constexpr size_t WS_ACT = WS_Q;
constexpr size_t WS_OUT4 = WS_GA;
constexpr size_t WS_TMPA = WS_X1, WS_TMPB = WS_X2;
constexpr int CW_CNT = 1024;

typedef unsigned short bf16;
typedef float f32x4 __attribute__((ext_vector_type(4)));
typedef unsigned u32x4 __attribute__((ext_vector_type(4)));
typedef unsigned u32x2 __attribute__((ext_vector_type(2)));

__device__ __forceinline__ unsigned f2bf(float f) { unsigned u = __builtin_bit_cast(unsigned, f); return (u + 0x7fffu + ((u >> 16) & 1u)) >> 16; }
__device__ __forceinline__ float bf2f(unsigned b) { return __builtin_bit_cast(float, (b & 0xffffu) << 16); }
__device__ __forceinline__ float wave_sum(float v) {
#pragma unroll
    for (int o = 1; o < 64; o <<= 1) v += __shfl_xor(v, o);
    return v;
}
__device__ __forceinline__ float sigmoidf_(float x) { return 1.0f / (1.0f + __expf(-x)); }
__device__ __forceinline__ float log_gamma_h(int h) { return log1pf(-exp2f(-5.0f - (float)h)); }

__device__ __forceinline__ void rot_cs(int pos, int d, float& c, float& s) {
    const double inv = exp2(-(double)d * (13.287712379549449 / 64.0));
    const double a = (double)pos * inv;
    const double n = rint(a * 0.15915494309189535);
    const double r = fma(-n, 6.283185307179586, a) - n * 2.4492935982947064e-16;
    c = (float)cos(r); s = (float)sin(r);
}

#ifndef MK_NAIVE
#define MK_NAIVE 1
#endif

#if MK_NAIVE
namespace nv {
__global__ void __launch_bounds__(256) rmsnorm_rows(const float* x, const float* g, bf16* ob, float* of, int M) {
    const int row = blockIdx.x * 4 + (threadIdx.x >> 6), lane = threadIdx.x & 63; if (row >= M) return;
    const float* xr = x + (size_t)row * DM; float v[16]; float s = 0.f;
#pragma unroll
    for (int j = 0; j < 16; ++j) { v[j] = xr[lane + 64 * j]; s += v[j] * v[j]; }
    const float rs = rsqrtf(wave_sum(s) * (1.0f / DM) + RMS_EPS);
#pragma unroll
    for (int j = 0; j < 16; ++j) { const float o = v[j] * rs * g[lane + 64 * j]; if (ob) ob[(size_t)row * DM + lane + 64 * j] = (bf16)f2bf(o); if (of) of[(size_t)row * DM + lane + 64 * j] = o; }
}
template <typename AT> __device__ __forceinline__ float lda_(const AT* p);
template <> __device__ __forceinline__ float lda_<float>(const float* p) { return *p; }
template <> __device__ __forceinline__ float lda_<bf16>(const bf16* p) { return bf2f(*p); }

template <class Epi> struct GArgs { const void* A; const int* rowmap; const unsigned* cntp; const float* W; unsigned long long wstride; int lda, rowshift, M, ldw, K, pad; Epi epi; };
template <class Epi, typename AT>
__global__ void __launch_bounds__(256) gemm(GArgs<Epi> ga) {
    const AT* A = (const AT*)ga.A; const int lda = ga.lda; const int* rowmap = ga.rowmap; const int rowshift = ga.rowshift; const unsigned* cntp = ga.cntp; const int M = ga.M;
    const float* W = ga.W; const int ldw = ga.ldw; const size_t wstride = ga.wstride; const int K = ga.K; const Epi epi = ga.epi;
    const int z = blockIdx.z; const int Mv = cntp ? (int)cntp[z] : M;
    const int r0 = blockIdx.y * 16; if (r0 >= Mv) return;
    const int p = blockIdx.x * 256 + threadIdx.x; int n0, n1; epi.cols(p, n0, n1);
    const float* Wz = W + (size_t)z * wstride;
    const AT* Ar[16];
#pragma unroll
    for (int r = 0; r < 16; ++r) { int rr = r0 + r; if (rr >= Mv) rr = Mv - 1; const int arow = rowmap ? (rowmap[(size_t)z * NT + rr] >> rowshift) : rr; Ar[r] = A + (size_t)arow * lda; }
    float acc0[16], acc1[16];
#pragma unroll
    for (int r = 0; r < 16; ++r) { acc0[r] = 0.f; acc1[r] = 0.f; }
    for (int k = 0; k < K; ++k) {
        const float b0 = Wz[(size_t)k * ldw + n0]; const float b1 = n1 >= 0 ? Wz[(size_t)k * ldw + n1] : 0.f;
#pragma unroll
        for (int r = 0; r < 16; ++r) { const float a = lda_<AT>(Ar[r] + k); acc0[r] = fmaf(a, b0, acc0[r]); acc1[r] = fmaf(a, b1, acc1[r]); }
    }
#pragma unroll
    for (int r = 0; r < 16; ++r) if (r0 + r < Mv) epi.store(z, r0 + r, p, acc0[r], acc1[r]);
}
struct EpiRot {
    const int* pos; bf16* out; int seg; float scale;
    __device__ void cols(int p, int& n0, int& n1) const { n0 = seg * 1024 + (p >> 6) * 128 + (p & 63); n1 = n0 + 64; }
    __device__ void store(int, int r, int p, float a0, float a1) const {
        float c, s; rot_cs(pos[r], p & 63, c, s);
        const int col = (p >> 6) * 128 + (p & 63);
        out[(size_t)r * DM + col] = (bf16)f2bf((a0 * c - a1 * s) * scale); out[(size_t)r * DM + col + 64] = (bf16)f2bf((a1 * c + a0 * s) * scale);
    }
};
struct EpiAct {
    bf16* out; int seg; int act;
    __device__ void cols(int p, int& n0, int& n1) const { n0 = seg * 1024 + p; n1 = -1; }
    __device__ void store(int, int r, int p, float a0, float) const {
        float v = a0; if (act == 1) v = a0 * sigmoidf_(a0); else if (act == 2) v = sigmoidf_(a0);
        out[(size_t)r * DM + p] = (bf16)f2bf(v);
    }
};
struct EpiGateA {
    const bf16* ga; float* out;
    __device__ void cols(int p, int& n0, int& n1) const { n0 = p; n1 = -1; }
    __device__ void store(int, int r, int p, float a0, float) const { out[(size_t)r * DM + p] = bf2f(ga[(size_t)r * DM + p]) * a0; }
};
struct EpiGateB {
    const bf16* gb; const float* t; bf16* out;
    __device__ void cols(int p, int& n0, int& n1) const { n0 = p; n1 = -1; }
    __device__ void store(int, int r, int p, float a0, float) const { out[(size_t)r * DM + p] = (bf16)f2bf(t[(size_t)r * DM + p] + bf2f(gb[(size_t)r * DM + p]) * a0); }
};
struct EpiResid {
    const float* base; float* out;
    __device__ void cols(int p, int& n0, int& n1) const { n0 = p; n1 = -1; }
    __device__ void store(int, int r, int p, float a0, float) const { out[(size_t)r * DM + p] = base[(size_t)r * DM + p] + a0; }
};
struct EpiBf16 {
    bf16* out; int ld; int pad;
    __device__ void cols(int p, int& n0, int& n1) const { n0 = p; n1 = -1; }
    __device__ void store(int, int r, int p, float a0, float) const { out[(size_t)r * ld + p] = (bf16)f2bf(a0); }
};
__device__ __forceinline__ float swiglu_(float g, float u) {
    g = fminf(g, SW_LIMIT); u = fminf(fmaxf(u, -SW_LIMIT), SW_LIMIT);
    return (u + 1.0f) * (g * sigmoidf_(g * SW_ALPHA));
}
struct EpiSwiglu {
    const float* bias; const unsigned* cnt; bf16* act;
    __device__ void cols(int p, int& n0, int& n1) const { n0 = p; n1 = 1024 + p; }
    __device__ void store(int z, int r, int p, float a0, float a1) const {
        unsigned st = 0; for (int e = 0; e < z; ++e) st += cnt[e];
        act[(size_t)(st + r) * DFF + p] = (bf16)f2bf(swiglu_(a0 + bias[(size_t)z * 2048 + p], a1 + bias[(size_t)z * 2048 + 1024 + p]));
    }
};
struct EpiDown {
    const float* bias; const int* rowlist; const float* roww; bf16* out4;
    __device__ void cols(int p, int& n0, int& n1) const { n0 = p; n1 = -1; }
    __device__ void store(int z, int r, int p, float a0, float) const {
        const int ent = rowlist[(size_t)z * NT + r]; const float w = roww[(size_t)z * NT + r];
        out4[(size_t)ent * DM + p] = (bf16)f2bf(w * (a0 + bias[(size_t)z * DM + p]));
    }
};
struct EpiPle {
    const float* x2; const bf16* pp; float* out;
    __device__ void cols(int p, int& n0, int& n1) const { n0 = p; n1 = -1; }
    __device__ void store(int, int r, int p, float a0, float) const { out[(size_t)r * DM + p] = x2[(size_t)r * DM + p] + sigmoidf_(a0) * bf2f(pp[(size_t)r * DM + p]); }
};
template <class Epi>
__global__ void __launch_bounds__(256) gemm_down(const bf16* act, const unsigned* cnt, const float* W, Epi epi) {
    const int z = blockIdx.z; const int Mv = (int)cnt[z];
    const int r0 = blockIdx.y * 16; if (r0 >= Mv) return;
    unsigned st = 0; for (int e = 0; e < z; ++e) st += cnt[e];
    const int p = blockIdx.x * 256 + threadIdx.x;
    const float* Wz = W + (size_t)z * DFF * DM;
    const bf16* Ar[16];
#pragma unroll
    for (int r = 0; r < 16; ++r) { int rr = r0 + r; if (rr >= Mv) rr = Mv - 1; Ar[r] = act + (size_t)(st + rr) * DFF; }
    float acc0[16];
#pragma unroll
    for (int r = 0; r < 16; ++r) acc0[r] = 0.f;
    for (int k = 0; k < DFF; ++k) {
        const float b0 = Wz[(size_t)k * DM + p];
#pragma unroll
        for (int r = 0; r < 16; ++r) acc0[r] = fmaf(bf2f(Ar[r][k]), b0, acc0[r]);
    }
#pragma unroll
    for (int r = 0; r < 16; ++r) if (r0 + r < Mv) epi.store(z, r0 + r, p, acc0[r], 0.f);
}

__global__ void __launch_bounds__(256) ret_kv(const bf16* K, const bf16* V, float* kvt) {
    const int n = blockIdx.x, bh = blockIdx.y, b = bh / NH, h = bh % NH; const float lg = log_gamma_h(h);
    const size_t row0 = (size_t)b * SEQ + (size_t)n * CH;
    __shared__ float sk[CH][DH + 1]; __shared__ float sv[CH][DH + 1];
    for (int i = threadIdx.x; i < CH * DH; i += 256) { const int j = i >> 7, c = i & 127; const float z = __expf(lg * (float)(CH - 1 - j));
        sk[j][c] = bf2f(K[(row0 + j) * DM + h * DH + c]); sv[j][c] = z * bf2f(V[(row0 + j) * DM + h * DH + c]); }
    __syncthreads();
    float* o = kvt + ((size_t)bh * NCH + n) * DH * DH;
    for (int i = threadIdx.x; i < DH * DH; i += 256) { const int e = i >> 7, d = i & 127; float a = 0.f;
        for (int j = 0; j < CH; ++j) a = fmaf(sk[j][d], sv[j][e], a);
        o[(size_t)e * DH + d] = a; }
}
__global__ void __launch_bounds__(256) ret_scan(const float* kvt, bf16* prevt) {
    const int idx = blockIdx.x * 256 + threadIdx.x; const int bh = idx / (DH * DH), ed = idx % (DH * DH); const int h = bh % NH;
    const float dec = __expf(log_gamma_h(h) * (float)CH); float st = 0.f;
    for (int n = 0; n < NCH; ++n) { const size_t o = ((size_t)bh * NCH + n) * DH * DH + ed; prevt[o] = (bf16)f2bf(st); st = st * dec + kvt[o]; }
}
__global__ void __launch_bounds__(128) ret_out(const bf16* Q, const bf16* K, const bf16* V, const bf16* prevt, const bf16* SG, const float* gn, bf16* YM) {
    const int t = blockIdx.x, h = blockIdx.y, b = t / SEQ, tt = t % SEQ, n = tt / CH, i = tt % CH, e = threadIdx.x; const float lg = log_gamma_h(h);
    __shared__ float sq[DH]; __shared__ float ss[CH]; __shared__ float red[4];
    sq[e] = bf2f(Q[(size_t)t * DM + h * DH + e]);
    __syncthreads();
    { const int j = e; float a = 0.f; if (j <= i) { const bf16* kr = K + ((size_t)b * SEQ + (size_t)n * CH + j) * DM + h * DH; for (int d = 0; d < DH; ++d) a = fmaf(sq[d], bf2f(kr[d]), a); a *= __expf(lg * (float)(i - j)); } ss[j] = a; }
    __syncthreads();
    float inner = 0.f; for (int j = 0; j <= i; ++j) inner = fmaf(ss[j], bf2f(V[((size_t)b * SEQ + (size_t)n * CH + j) * DM + h * DH + e]), inner);
    const bf16* pt = prevt + (((size_t)(b * NH + h)) * NCH + n) * DH * DH + (size_t)e * DH; float cr = 0.f;
    for (int d = 0; d < DH; ++d) cr = fmaf(sq[d], bf2f(pt[d]), cr);
    const float r = inner + __expf(lg * (float)(i + 1)) * cr;
    float s1 = wave_sum(r); if ((e & 63) == 0) red[e >> 6] = s1; __syncthreads(); const float mu = (red[0] + red[1]) * (1.0f / DH);
    const float dv = r - mu; float s2 = wave_sum(dv * dv); if ((e & 63) == 0) red[2 + (e >> 6)] = s2; __syncthreads(); const float var = (red[2] + red[3]) * (1.0f / DH);
    const float y = dv * rsqrtf(var + GN_EPS) * gn[h * DH + e];
    const float yb = bf2f(f2bf(y));
    (void)yb;
    YM[(size_t)t * 2048 + h * DH + e] = (bf16)f2bf(bf2f(SG[(size_t)t * DM + h * DH + e]) * y);
}
__global__ void __launch_bounds__(256) pool_mixed(const bf16* U, bf16* YM) {
    const size_t idx = (size_t)blockIdx.x * 256 + threadIdx.x; const int t = (int)(idx >> 10), c = (int)(idx & 1023); const int tt = t % SEQ; const int w = 2 << (c >> 8);
    const int cnt = tt + 1 < w ? tt + 1 : w; float s = 0.f;
    for (int k = 0; k < cnt; ++k) s += bf2f(U[(size_t)(t - k) * DM + c]);
    YM[(size_t)t * 2048 + 1024 + c] = (bf16)f2bf(s / (float)cnt - bf2f(U[(size_t)t * DM + c]));
}
__global__ void __launch_bounds__(256) pool_proj(const bf16* YM, const float* wp, const float* scale, float* out) {
    const int g = blockIdx.x, r0 = blockIdx.y * 16, dd = threadIdx.x; float acc[16];
#pragma unroll
    for (int r = 0; r < 16; ++r) acc[r] = 0.f;
    for (int c = 0; c < 256; ++c) { const float w = wp[((size_t)g * 256 + c) * 256 + dd];
#pragma unroll
        for (int r = 0; r < 16; ++r) acc[r] = fmaf(bf2f(YM[(size_t)(r0 + r) * 2048 + 1024 + g * 256 + c]), w, acc[r]); }
#pragma unroll
    for (int r = 0; r < 16; ++r) out[(size_t)(r0 + r) * DM + g * 256 + dd] = acc[r] * scale[g * 256 + dd];
}
__global__ void __launch_bounds__(256) router(const float* x1, const float* g, const float* wr, const float* br, bf16* h2, int* tope, float* topw) {
    const int t = blockIdx.x * 4 + (threadIdx.x >> 6), lane = threadIdx.x & 63;
    const float* xr = x1 + (size_t)t * DM; float v[16]; float s = 0.f;
#pragma unroll
    for (int j = 0; j < 16; ++j) { v[j] = xr[lane + 64 * j]; s += v[j] * v[j]; }
    const float rs = rsqrtf(wave_sum(s) * (1.0f / DM) + RMS_EPS);
#pragma unroll
    for (int j = 0; j < 16; ++j) { v[j] = v[j] * rs * g[lane + 64 * j]; h2[(size_t)t * DM + lane + 64 * j] = (bf16)f2bf(v[j]); }
    const int e = lane & 31; float lg = 0.f;
#pragma unroll
    for (int j = 0; j < 16; ++j)
        for (int l = 0; l < 64; ++l) { const float hv = __shfl(v[j], l); lg = fmaf(hv, wr[(size_t)(l + 64 * j) * NE + e], lg); }
    lg += br[e];
    float val = lg; int sel[4]; float sv[4];
#pragma unroll
    for (int k = 0; k < 4; ++k) {
        float m = val; int mi = e;
#pragma unroll
        for (int o = 1; o < 32; o <<= 1) { const float om = __shfl_xor(m, o); const int oi = __shfl_xor(mi, o); if (om > m || (om == m && oi < mi)) { m = om; mi = oi; } }
        sel[k] = mi; sv[k] = m; if (e == mi) val = -INFINITY;
    }
    const float e0 = 1.f, e1 = __expf(sv[1] - sv[0]), e2 = __expf(sv[2] - sv[0]), e3 = __expf(sv[3] - sv[0]); const float inv = 1.f / (e0 + e1 + e2 + e3);
    if (lane == 0) { tope[t * 4 + 0] = sel[0]; tope[t * 4 + 1] = sel[1]; tope[t * 4 + 2] = sel[2]; tope[t * 4 + 3] = sel[3];
        topw[t * 4 + 0] = e0 * inv; topw[t * 4 + 1] = e1 * inv; topw[t * 4 + 2] = e2 * inv; topw[t * 4 + 3] = e3 * inv; }
}
__global__ void __launch_bounds__(64) build_lists(const int* tope, const float* topw, int* rowlist, float* roww, unsigned* cnt) {
    const int e = blockIdx.x, lane = threadIdx.x; unsigned base = 0;
    for (int a0 = 0; a0 < NT * TOPK; a0 += 64) { const int a = a0 + lane; const bool hit = tope[a] == e;
        const unsigned long long m = __ballot(hit); const unsigned before = __popcll(m & ((1ull << lane) - 1ull));
        if (hit) { rowlist[(size_t)e * NT + base + before] = a; roww[(size_t)e * NT + base + before] = topw[a]; }
        base += __popcll(m); }
    if (lane == 0) cnt[e] = base;
}
__global__ void __launch_bounds__(256) combine(const float* x1, const bf16* out4, const float* g, float* x2, bf16* h3) {
    const int t = blockIdx.x * 4 + (threadIdx.x >> 6), lane = threadIdx.x & 63; float v[16]; float s = 0.f;
#pragma unroll
    for (int j = 0; j < 16; ++j) { const int c = lane + 64 * j; float a = x1[(size_t)t * DM + c];
        for (int k = 0; k < 4; ++k) a += bf2f(out4[((size_t)t * 4 + k) * DM + c]);
        v[j] = a; s += a * a; x2[(size_t)t * DM + c] = a; }
    const float rs = rsqrtf(wave_sum(s) * (1.0f / DM) + RMS_EPS);
#pragma unroll
    for (int j = 0; j < 16; ++j) h3[(size_t)t * DM + lane + 64 * j] = (bf16)f2bf(v[j] * rs * g[lane + 64 * j]);
}
__global__ void __launch_bounds__(256) final_norm(float* out, const float* g) {
    const int row = blockIdx.x * 4 + (threadIdx.x >> 6), lane = threadIdx.x & 63; float* xr = out + (size_t)row * DM; float v[16]; float s = 0.f;
#pragma unroll
    for (int j = 0; j < 16; ++j) { v[j] = xr[lane + 64 * j]; s += v[j] * v[j]; }
    const float rs = rsqrtf(wave_sum(s) * (1.0f / DM) + RMS_EPS);
#pragma unroll
    for (int j = 0; j < 16; ++j) xr[lane + 64 * j] = v[j] * rs * g[lane + 64 * j];
}
}

template <class Epi, typename AT>
static void launch_gemm(hipStream_t st, dim3 grid, const AT* A, int lda, const int* rowmap, int rowshift, const unsigned* cntp, int M, const float* W, int ldw, size_t wstride, int K, const Epi& epi) {
    nv::GArgs<Epi> a; memset(&a, 0, sizeof(a));
    a.A = A; a.rowmap = rowmap; a.cntp = cntp; a.W = W; a.wstride = wstride; a.lda = lda; a.rowshift = rowshift; a.M = M; a.ldw = ldw; a.K = K; a.epi = epi;
    nv::gemm<Epi, AT><<<grid, 256, 0, st>>>(a);
}
enum { S_H = 1, S_G1 = 2, S_RKV = 4, S_SCAN = 8, S_ROUT = 16, S_POOL = 32, S_MERGE = 64, S_X1 = 128, S_ROUTER = 256, S_GU = 512, S_DOWN = 1024, S_COMB = 2048, S_PP = 4096, S_PLE = 8192, S_FIN = 16384 };
static void naive_forward(void* const* d_in, float* out, unsigned char* ws, hipStream_t st, unsigned run) {
    const float* x = (const float*)d_in[0]; const float* p = (const float*)d_in[1]; const int* pos = (const int*)d_in[2];
    const float* g_mix = (const float*)d_in[3]; const float* w_in = (const float*)d_in[4]; const float* g_ret = (const float*)d_in[5];
    const float* w_pool = (const float*)d_in[6]; const float* pool_scale = (const float*)d_in[7]; const float* w_branch = (const float*)d_in[8];
    const float* w_out = (const float*)d_in[9]; const float* g_ffn = (const float*)d_in[10]; const float* w_router = (const float*)d_in[11];
    const float* b_router = (const float*)d_in[12]; const float* w_gu = (const float*)d_in[13]; const float* b_gu = (const float*)d_in[14];
    const float* w_down = (const float*)d_in[15]; const float* b_down = (const float*)d_in[16]; const float* g_ple = (const float*)d_in[17];
    const float* w_pg = (const float*)d_in[18]; const float* w_pp = (const float*)d_in[19]; const float* g_final = (const float*)d_in[20];
    bf16* H = (bf16*)(ws + WS_H); bf16* Q = (bf16*)(ws + WS_Q); bf16* K = (bf16*)(ws + WS_K); bf16* V = (bf16*)(ws + WS_V);
    bf16* SG = (bf16*)(ws + WS_SG); bf16* U = (bf16*)(ws + WS_U); bf16* GA = (bf16*)(ws + WS_GA); bf16* GB = (bf16*)(ws + WS_GB);
    float* KVT = (float*)(ws + WS_KVT); bf16* PREVT = (bf16*)(ws + WS_PREVT); bf16* YM = (bf16*)(ws + WS_YM); bf16* MERGED = (bf16*)(ws + WS_MERGED);
    float* X1 = (float*)(ws + WS_X1); bf16* H2 = (bf16*)(ws + WS_H2); float* X2 = (float*)(ws + WS_X2); bf16* H3 = (bf16*)(ws + WS_H3);
    bf16* ACT = (bf16*)(ws + WS_ACT); bf16* OUT4 = (bf16*)(ws + WS_OUT4); bf16* PP = (bf16*)(ws + WS_PP);
    float* TMPA = (float*)(ws + WS_TMPA); float* TMPB = (float*)(ws + WS_TMPB);
    int* TOPE = (int*)(ws + WS_TOPE); float* TOPW = (float*)(ws + WS_TOPW); int* ROWLIST = (int*)(ws + WS_ROWLIST); float* ROWW = (float*)(ws + WS_ROWW);
    unsigned* CNT = (unsigned*)(ws + WS_CTL) + CW_CNT;
    if (run & S_H) nv::rmsnorm_rows<<<NT / 4, 256, 0, st>>>(x, g_mix, H, nullptr, NT);
    if (run & S_G1) launch_gemm<nv::EpiRot, bf16>(st, dim3(2, NT / 16, 1), H, DM, nullptr, 0, nullptr, NT, w_in, INW, 0, DM, nv::EpiRot{pos, Q, 0, 1.0f});
    if (run & S_G1) launch_gemm<nv::EpiRot, bf16>(st, dim3(2, NT / 16, 1), H, DM, nullptr, 0, nullptr, NT, w_in, INW, 0, DM, nv::EpiRot{pos, K, 1, 0.08838834764831845f});
    if (run & S_G1) launch_gemm<nv::EpiAct, bf16>(st, dim3(4, NT / 16, 1), H, DM, nullptr, 0, nullptr, NT, w_in, INW, 0, DM, nv::EpiAct{V, 2, 0});
    if (run & S_G1) launch_gemm<nv::EpiAct, bf16>(st, dim3(4, NT / 16, 1), H, DM, nullptr, 0, nullptr, NT, w_in, INW, 0, DM, nv::EpiAct{SG, 3, 1});
    if (run & S_G1) launch_gemm<nv::EpiAct, bf16>(st, dim3(4, NT / 16, 1), H, DM, nullptr, 0, nullptr, NT, w_in, INW, 0, DM, nv::EpiAct{U, 4, 0});
    if (run & S_G1) launch_gemm<nv::EpiAct, bf16>(st, dim3(4, NT / 16, 1), H, DM, nullptr, 0, nullptr, NT, w_in, INW, 0, DM, nv::EpiAct{GA, 5, 2});
    if (run & S_G1) launch_gemm<nv::EpiAct, bf16>(st, dim3(4, NT / 16, 1), H, DM, nullptr, 0, nullptr, NT, w_in, INW, 0, DM, nv::EpiAct{GB, 6, 2});
    if (run & S_RKV) nv::ret_kv<<<dim3(NCH, NB * NH), 256, 0, st>>>(K, V, KVT);
    if (run & S_SCAN) nv::ret_scan<<<NB * NH * DH * DH / 256, 256, 0, st>>>(KVT, PREVT);
    if (run & S_ROUT) nv::ret_out<<<dim3(NT, NH), 128, 0, st>>>(Q, K, V, PREVT, SG, g_ret, YM);
    if (run & S_POOL) nv::pool_mixed<<<NT * DM / 256, 256, 0, st>>>(U, YM);
    if (run & S_MERGE) nv::pool_proj<<<dim3(4, NT / 16), 256, 0, st>>>(YM, w_pool, pool_scale, TMPA);
    if (run & S_MERGE) launch_gemm<nv::EpiGateA, bf16>(st, dim3(4, NT / 16, 1), YM, 2048, nullptr, 0, nullptr, NT, w_branch, DM, 0, DM, nv::EpiGateA{GA, TMPB});
    if (run & S_MERGE) launch_gemm<nv::EpiGateB, float>(st, dim3(4, NT / 16, 1), TMPA, DM, nullptr, 0, nullptr, NT, w_branch + (size_t)DM * DM, DM, 0, DM, nv::EpiGateB{GB, TMPB, MERGED});
    if (run & S_X1) launch_gemm<nv::EpiResid, bf16>(st, dim3(4, NT / 16, 1), MERGED, DM, nullptr, 0, nullptr, NT, w_out, DM, 0, DM, nv::EpiResid{x, X1});
    if (run & S_ROUTER) nv::router<<<NT / 4, 256, 0, st>>>(X1, g_ffn, w_router, b_router, H2, TOPE, TOPW);
    if (run & S_ROUTER) nv::build_lists<<<NE, 64, 0, st>>>(TOPE, TOPW, ROWLIST, ROWW, CNT);
    if (run & S_GU) launch_gemm<nv::EpiSwiglu, bf16>(st, dim3(4, NT / 16, NE), H2, DM, ROWLIST, 2, CNT, NT, w_gu, 2048, (size_t)DM * 2048, DM, nv::EpiSwiglu{b_gu, CNT, ACT});
    if (run & S_DOWN) nv::gemm_down<nv::EpiDown><<<dim3(4, NT / 16, NE), 256, 0, st>>>(ACT, CNT, w_down, nv::EpiDown{b_down, ROWLIST, ROWW, OUT4});
    if (run & S_COMB) nv::combine<<<NT / 4, 256, 0, st>>>(X1, OUT4, g_ple, X2, H3);
    if (run & S_PP) launch_gemm<nv::EpiBf16, float>(st, dim3(4, NT / 16, 1), p, PLE, nullptr, 0, nullptr, NT, w_pp, DM, 0, PLE, nv::EpiBf16{PP, DM, 0});
    if (run & S_PLE) launch_gemm<nv::EpiPle, bf16>(st, dim3(4, NT / 16, 1), H3, DM, nullptr, 0, nullptr, NT, w_pg, DM, 0, DM, nv::EpiPle{X2, PP, out});
    if (run & S_FIN) nv::final_norm<<<NT / 4, 256, 0, st>>>(out, g_final);
}
#endif


#define LAS __attribute__((address_space(3)))
#define GAS __attribute__((address_space(1)))
typedef short bf16x8 __attribute__((ext_vector_type(8)));
typedef GAS unsigned gu32;
#define RLX_AGENT __ATOMIC_RELAXED, __HIP_MEMORY_SCOPE_AGENT
#define LDS_WAIT() asm volatile("s_waitcnt lgkmcnt(0)" ::: "memory")
#define VM_WAIT() asm volatile("s_waitcnt vmcnt(0)" ::: "memory")
__device__ __forceinline__ unsigned pk2(float lo, float hi) { return f2bf(lo) | (f2bf(hi) << 16); }
typedef float f32x2_t __attribute__((ext_vector_type(2))); typedef __bf16 bf16x2_t __attribute__((ext_vector_type(2)));
__device__ __forceinline__ unsigned cvt_pk_bf16(float lo, float hi) { f32x2_t v = {lo, hi}; bf16x2_t b = __builtin_convertvector(v, bf16x2_t); return __builtin_bit_cast(unsigned, b); }
__device__ __forceinline__ float fast_sigmoid(float x) { return __builtin_amdgcn_rcpf(1.0f + __builtin_amdgcn_exp2f(-1.4426950408889634f * x)); }

constexpr int NWAVES = 8;
constexpr int RING_OFF = 0, RING_BYTES = 131072;
constexpr int LDSCTL_OFF = RING_BYTES, MISC_OFF = LDSCTL_OFF + 320;
constexpr int LDS_TAB_OFF = LDSCTL_OFF + 1024;
constexpr int LDS_BYTES = 163840;
static_assert(LDS_TAB_OFF + 6480 * 4 <= LDS_BYTES, "LDS table region");
constexpr int CW_BAR = 4096;

#define XB_TMO      128
#define XB_XCNT(j)  (256  + 64 * (j))
#define XB_XSUB(j)  (1280 + 64 * (j))
#define XB_XGEN(j)  (2304 + 64 * (j))
#define XB_TOP      3328
#define XB_TOPGEN   3392
#define XCD_BAR_WORDS 3456
#define XB_SPIN_CAP (1u << 18)
__device__ __forceinline__ unsigned xb_ld(unsigned* p)              { return __hip_atomic_load(p, __ATOMIC_RELAXED, __HIP_MEMORY_SCOPE_AGENT); }
__device__ __forceinline__ unsigned xb_add(unsigned* p, unsigned v) { return __hip_atomic_fetch_add(p, v, __ATOMIC_RELAXED, __HIP_MEMORY_SCOPE_AGENT); }
__device__ __forceinline__ unsigned xb_xcc_id() { return (unsigned)__builtin_amdgcn_s_getreg((3 << 11) | 20) & 0xFu; }
#define XB_SPIN(cond, bar) do { unsigned _sp = 0; while (cond) { __builtin_amdgcn_s_sleep(1); \
    if ((++_sp & 255u) == 0u) { if (xb_ld(&(bar)[XB_TMO])) break; if (_sp > XB_SPIN_CAP) { atomicAdd(&(bar)[XB_TMO], 1u); break; } } } } while (0)
struct XcdBarrier { unsigned* bar; unsigned x; volatile LAS unsigned* st; };
__device__ __forceinline__ XcdBarrier xcd_barrier_post(unsigned* bar, volatile LAS unsigned* st) {
    XcdBarrier b; b.bar = bar; b.x = xb_xcc_id(); b.st = st;
    if (threadIdx.x == 0) (void)xb_add(&bar[XB_XCNT(b.x)], 1u);
    return b;
}
__device__ __forceinline__ void xcd_barrier_complete(unsigned* bar, unsigned x, unsigned& nloc, unsigned& nx) {
    const unsigned G = gridDim.x * gridDim.y * gridDim.z;
    unsigned sum, cnt, mine, sp = 0u;
    for (;;) {
        sum = 0u; cnt = 0u; mine = 0u;
#pragma unroll
        for (unsigned j = 0; j < 16; ++j) { const unsigned c = xb_ld(&bar[XB_XCNT(j)]); sum += c; cnt += (c > 0u) ? 1u : 0u; mine = (j == x) ? c : mine; }
        if (sum == G) break;
        __builtin_amdgcn_s_sleep(1);
        if ((++sp & 255u) == 0u) { if (xb_ld(&bar[XB_TMO])) break; if (sp > XB_SPIN_CAP) { atomicAdd(&bar[XB_TMO], 1u); break; } }
    }
    nloc = mine > 0u ? mine : 1u; nx = cnt > 0u ? cnt : 1u;
}
__device__ __forceinline__ void xcd_barrier(const XcdBarrier& b) {
    asm volatile("s_waitcnt vmcnt(0)" ::: "memory");
    __syncthreads();
    if (threadIdx.x == 0) {
        unsigned* bar = b.bar;
        __builtin_amdgcn_s_waitcnt(0);
        unsigned nloc = b.st[0], nx = b.st[1];
        if (nloc == 0u) { xcd_barrier_complete(bar, b.x, nloc, nx); b.st[0] = nloc; b.st[1] = nx; }
        const unsigned old = xb_add(&bar[XB_XSUB(b.x)], 1u);
        const unsigned gen = old / nloc;
        if (old + 1u == (gen + 1u) * nloc) {
            __builtin_amdgcn_fence(__ATOMIC_RELEASE, "agent");
            asm volatile("s_waitcnt vmcnt(0)" ::: "memory");
            const unsigned og = xb_add(&bar[XB_TOP], 1u);
            const unsigned tg = og / nx;
            if (og + 1u == (tg + 1u) * nx) xb_add(&bar[XB_TOPGEN], 1u);
            else XB_SPIN(xb_ld(&bar[XB_TOPGEN]) == tg, bar);
            __builtin_amdgcn_fence(__ATOMIC_ACQUIRE, "agent");
            xb_add(&bar[XB_XGEN(b.x)], 1u);
            asm volatile("s_waitcnt vmcnt(0)" ::: "memory");
        } else {
            XB_SPIN(xb_ld(&bar[XB_XGEN(b.x)]) == gen, bar);
            __builtin_amdgcn_fence(__ATOMIC_ACQUIRE, "agent");
            asm volatile("s_waitcnt vmcnt(0)" ::: "memory");
        }
    }
    __syncthreads();
}

namespace pg8 {
constexpr int BM = 256, BK = 64, HALF = 128, HTB = HALF * BK * 2, STAGE_BYTES = 8 * HTB, NXCD = 8, WGM = 8;
__host__ __device__ __forceinline__ int lds_byte(int r, int c) { const int st = (r >> 4) * 2 + (c >> 5), rr = r & 15, cc = c & 31, ob = rr * 64 + cc * 2; return st * 1024 + (ob ^ (((ob >> 9) & 1) << 5)); }
__host__ __device__ __forceinline__ void stage_rc(int b, int& R, int& C) { const int st = b / 1024, sb = b % 1024, swz = sb ^ (((sb >> 9) & 1) << 5); R = (st >> 1) * 16 + swz / 64; C = (st & 1) * 32 + (swz % 64) / 2; }
__host__ __device__ __forceinline__ int perm32(int rho) { const int n = rho >> 4, i = rho & 15; return 8 * (i >> 2) + 4 * n + (i & 3); }

struct Unit { int pm, pn, e, nvalid; unsigned aoff, boff; int slot, keep; };
typedef f32x4 Acc[2][2][4][2];

struct StaticOrder {
    int nM, nN, nwg, G, c, K;
    __device__ void init(int M, int N, int K_, int G_, int c_) { nM = M / BM; nN = N / BM; nwg = nM * nN; G = G_; c = c_; K = K_; }
    __device__ bool next(int i, Unit& u) const {
        const long L = (long)i * G + c; if (L >= nwg) return false;
        int wgid = (int)L; { const int q = nwg / NXCD, r = nwg % NXCD, xcd = wgid % NXCD, off = wgid / NXCD; wgid = (xcd < r ? xcd * (q + 1) : r * (q + 1) + (xcd - r) * q) + off; }
        const int nig = WGM * nN, gid = wgid / nig, fm = gid * WGM, gsz = (nM - fm) < WGM ? (nM - fm) : WGM;
        u.pm = fm + ((wgid % nig) % gsz); u.pn = (wgid % nig) / gsz; u.e = 0; u.nvalid = BM; u.slot = 0; u.keep = 0;
        u.aoff = (unsigned)u.pm * (unsigned)(BM * K * 2); u.boff = (unsigned)u.pn * (unsigned)(BM * K * 2); return true;
    }
    __device__ __forceinline__ void gather(const Unit&, unsigned (&)[2][2]) const {}
};

struct TwoPartOrder {
    StaticOrder base;
    __device__ bool next(int i, Unit& u) const {
        if (!base.next(i >> 1, u)) return false;
        const int part = i & 1; u.aoff = (unsigned)u.pm * (unsigned)(BM * 2048 * 2) + (unsigned)part * 2048u; u.boff = (unsigned)u.pn * (unsigned)(BM * 2048 * 2) + (unsigned)part * 2048u; u.keep = part == 0; return true;
    }
    __device__ __forceinline__ void gather(const Unit&, unsigned (&)[2][2]) const {}
};
template <class Epi, class Sched, bool ALIGN_EPI, bool GATHER>
__device__ __forceinline__ void gemm_phase(LAS unsigned char* lds, const int K, const int lda, const int ldb, const char* Ab, const char* Bb, const Sched& S, const Epi& E) {
    const int tid = threadIdx.x, wid = __builtin_amdgcn_readfirstlane(tid >> 6), lane = tid & 63, wr = wid >> 2, wc = wid & 3, fr = lane & 15, fq = lane >> 4;
    const int nt = K / BK;
    unsigned voffA[2][2], voffB[2];
    const unsigned hstep = (unsigned)(HALF * ldb * 2);
#pragma unroll
    for (int i = 0; i < 2; ++i) { int R, C; stage_rc(tid * 16 + i * 8192, R, C); const int Rb = Epi::PERM ? ((R & ~31) + perm32(R & 31)) : R;
        voffA[0][i] = (unsigned)(R * lda + C) * 2u; voffA[1][i] = voffA[0][i] + (unsigned)(HALF * lda * 2); voffB[i] = (unsigned)(Rb * ldb + C) * 2u; }
    const size_t kstep = (size_t)(BK * 2);
    const unsigned ldsw = (unsigned)wid * 1024u;
    const int aoff = lds_byte(wr * 64 + fr, fq * 8), boff = lds_byte(wc * 32 + fr, fq * 8);
#define PG8_SA(b, h) (((b) * 2 + (h)) * HTB)
#define PG8_SB(b, h) ((4 + (b) * 2 + (h)) * HTB)
#define PG8_STAGE(bufoff, gbase, voff) do { _Pragma("unroll") for (int _i = 0; _i < 2; ++_i) \
        __builtin_amdgcn_global_load_lds((const unsigned*)((const char*)(gbase) + (voff)[_i]), (LAS unsigned*)(lds + (bufoff) + ldsw + _i * 8192), 16, 0, 0); } while (0)
#define PG8_LDA(dst, b, h) do { _Pragma("unroll") for (int m = 0; m < 4; ++m) _Pragma("unroll") for (int k = 0; k < 2; ++k) dst[m][k] = *(const LAS bf16x8*)(lds + PG8_SA(b, h) + aoff + m * 2048 + k * 1024); } while (0)
#define PG8_LDB(dst, b, h) do { _Pragma("unroll") for (int n = 0; n < 2; ++n) _Pragma("unroll") for (int k = 0; k < 2; ++k) dst[n][k] = *(const LAS bf16x8*)(lds + PG8_SB(b, h) + boff + n * 2048 + k * 1024); } while (0)
#define PG8_MMA(ai, bj, At, Bt) do { __builtin_amdgcn_s_setprio(1); _Pragma("unroll") for (int m = 0; m < 4; ++m) _Pragma("unroll") for (int n = 0; n < 2; ++n) _Pragma("unroll") for (int k = 0; k < 2; ++k) \
        acc[ai][bj][m][n] = __builtin_amdgcn_mfma_f32_16x16x32_bf16(Bt[n][k], At[m][k], acc[ai][bj][m][n], 0, 0, 0); __builtin_amdgcn_s_setprio(0); } while (0)
#define PG8_WAIT_V(n) asm volatile("s_waitcnt vmcnt(" #n ")" ::: "memory")
#define PG8_WAIT_L(n) asm volatile("s_waitcnt lgkmcnt(" #n ")" ::: "memory")
#define PG8_BAR __builtin_amdgcn_s_barrier()
#define PG8_SCHED __builtin_amdgcn_sched_barrier(0)
    Unit cur, nxt; int ui = 0;
    if (!S.next(0, cur)) return;
    Acc acc;
#pragma unroll
    for (int a = 0; a < 2; ++a)
#pragma unroll
        for (int b = 0; b < 2; ++b)
#pragma unroll
            for (int m = 0; m < 4; ++m)
#pragma unroll
                for (int n = 0; n < 2; ++n) acc[a][b][m][n] = (f32x4){0.f, 0.f, 0.f, 0.f};
    bf16x8 At[4][2], B0[2][2], B1[2][2];
    const char* cA = Ab + cur.aoff; const char* cB = Bb + cur.boff;
    if constexpr (GATHER) S.gather(cur, voffA);
    PG8_STAGE(PG8_SB(0, 0), cB, voffB); PG8_STAGE(PG8_SB(0, 1), cB + hstep, voffB); PG8_STAGE(PG8_SA(0, 0), cA, voffA[0]); PG8_STAGE(PG8_SA(0, 1), cA, voffA[1]);
    if (wr == 1) PG8_BAR;
    PG8_WAIT_V(2); PG8_BAR;
    PG8_STAGE(PG8_SB(1, 0), cB + kstep, voffB); PG8_STAGE(PG8_SA(1, 0), cA + kstep, voffA[0]); PG8_STAGE(PG8_SB(1, 1), cB + hstep + kstep, voffB);
    PG8_WAIT_V(6); PG8_BAR;
    for (;;) {
        const bool has_next = S.next(ui + 1, nxt);
        const char* nA = has_next ? Ab + nxt.aoff : cA; const char* nB = has_next ? Bb + nxt.boff : cB;
        for (int t = 0; t < nt; t += 2) {
            const bool last = (t == nt - 2);
            const char* a1 = cA + (size_t)(t + 1) * kstep;
            const char* a2 = last ? nA : cA + (size_t)(t + 2) * kstep; const char* b2 = last ? nB : cB + (size_t)(t + 2) * kstep;
            const char* a3 = a2 + kstep; const char* b3 = b2 + kstep;
            PG8_LDB(B0, 0, 0); PG8_LDB(B1, 0, 1); PG8_SCHED; PG8_LDA(At, 0, 0); PG8_STAGE(PG8_SA(1, 1), a1, voffA[1]);
            if constexpr (GATHER) { if (last && has_next) S.gather(nxt, voffA); }
            PG8_WAIT_V(8); PG8_WAIT_L(0); PG8_BAR; PG8_MMA(0, 0, At, B0); PG8_MMA(0, 1, At, B1); PG8_BAR; PG8_SCHED;
            PG8_LDA(At, 0, 1); PG8_STAGE(PG8_SB(0, 0), b2, voffB); PG8_STAGE(PG8_SB(0, 1), b2 + hstep, voffB); PG8_STAGE(PG8_SA(0, 0), a2, voffA[0]);
            PG8_WAIT_V(8); PG8_WAIT_L(0); PG8_BAR; PG8_MMA(1, 0, At, B0); PG8_MMA(1, 1, At, B1); PG8_BAR; PG8_SCHED;
            PG8_LDB(B0, 1, 0); PG8_LDB(B1, 1, 1); PG8_SCHED; PG8_LDA(At, 1, 0); PG8_STAGE(PG8_SA(0, 1), a2, voffA[1]);
            PG8_WAIT_V(8); PG8_WAIT_L(0); PG8_BAR; PG8_MMA(0, 0, At, B0); PG8_MMA(0, 1, At, B1); PG8_BAR; PG8_SCHED;
            PG8_LDA(At, 1, 1); PG8_STAGE(PG8_SB(1, 0), b3, voffB); PG8_STAGE(PG8_SB(1, 1), b3 + hstep, voffB); PG8_STAGE(PG8_SA(1, 0), a3, voffA[0]);
            PG8_WAIT_V(8); PG8_WAIT_L(0); PG8_BAR; PG8_MMA(1, 0, At, B0); PG8_MMA(1, 1, At, B1); PG8_BAR; PG8_SCHED;
        }
        if constexpr (ALIGN_EPI) { if (wr == 0) PG8_BAR; }
        E(acc, cur, wr, wc, fr, fq);
        if (!has_next) break;
#pragma unroll
        for (int a = 0; a < 2; ++a)
#pragma unroll
            for (int b = 0; b < 2; ++b)
#pragma unroll
                for (int m = 0; m < 4; ++m)
#pragma unroll
                    for (int n = 0; n < 2; ++n) acc[a][b][m][n] = (f32x4){0.f, 0.f, 0.f, 0.f};
        cur = nxt; cA = nA; cB = nB; ++ui;
        if constexpr (ALIGN_EPI) { if (wr == 1) PG8_BAR; }
    }
    PG8_WAIT_V(0);
    if constexpr (!ALIGN_EPI) { if (wr == 0) PG8_BAR; }
    PG8_BAR;
#undef PG8_SA
#undef PG8_SB
#undef PG8_STAGE
#undef PG8_LDA
#undef PG8_LDB
#undef PG8_MMA
#undef PG8_WAIT_V
#undef PG8_WAIT_L
#undef PG8_BAR
#undef PG8_SCHED
}

struct EpiIn {
    static constexpr bool PERM = true;
    bf16* outs;
    const float* trig;
    __device__ __forceinline__ void operator()(Acc& acc, const Unit& u, int wr, int wc, int fr, int fq) const {
        const int seg = u.pn >> 2, pl = u.pn & 3; const int row0 = u.pm * BM + wr * 64 + fr;
        bf16* base = outs + (size_t)seg * NT * DM;
        if (seg < 2) {
            const float sc = seg == 1 ? 0.08838834764831845f : 1.0f;
            const int head = 2 * pl + (wc >> 1), d0 = 32 * (wc & 1) + 8 * fq;
#pragma unroll
            for (int ai = 0; ai < 2; ++ai)
#pragma unroll
                for (int m = 0; m < 4; ++m) { const int row = row0 + ai * HALF + m * 16;
                    const f32x4* tp = (const f32x4*)(trig + ((size_t)row * 64 + d0) * 2);
                    const f32x4 t0 = tp[0], t1 = tp[1], t2 = tp[2], t3 = tp[3];
                    const f32x4 x1a = acc[ai][0][m][0], x1b = acc[ai][0][m][1], x2a = acc[ai][1][m][0], x2b = acc[ai][1][m][1];
                    u32x4 o1, o2;
                    o1.x = cvt_pk_bf16((x1a[0] * t0[0] - x2a[0] * t0[1]) * sc, (x1a[1] * t0[2] - x2a[1] * t0[3]) * sc);
                    o1.y = cvt_pk_bf16((x1a[2] * t1[0] - x2a[2] * t1[1]) * sc, (x1a[3] * t1[2] - x2a[3] * t1[3]) * sc);
                    o1.z = cvt_pk_bf16((x1b[0] * t2[0] - x2b[0] * t2[1]) * sc, (x1b[1] * t2[2] - x2b[1] * t2[3]) * sc);
                    o1.w = cvt_pk_bf16((x1b[2] * t3[0] - x2b[2] * t3[1]) * sc, (x1b[3] * t3[2] - x2b[3] * t3[3]) * sc);
                    o2.x = cvt_pk_bf16((x2a[0] * t0[0] + x1a[0] * t0[1]) * sc, (x2a[1] * t0[2] + x1a[1] * t0[3]) * sc);
                    o2.y = cvt_pk_bf16((x2a[2] * t1[0] + x1a[2] * t1[1]) * sc, (x2a[3] * t1[2] + x1a[3] * t1[3]) * sc);
                    o2.z = cvt_pk_bf16((x2b[0] * t2[0] + x1b[0] * t2[1]) * sc, (x2b[1] * t2[2] + x1b[1] * t2[3]) * sc);
                    o2.w = cvt_pk_bf16((x2b[2] * t3[0] + x1b[2] * t3[1]) * sc, (x2b[3] * t3[2] + x1b[3] * t3[3]) * sc);
                    bf16* rp = base + (size_t)row * DM + head * DH + d0;
                    *(u32x4*)rp = o1; *(u32x4*)(rp + 64) = o2; }
        } else {
            const int act = (seg == 3) ? 1 : (seg >= 5 ? 2 : 0);
            const int col0 = pl * BM + wc * 32 + 8 * fq;
#pragma unroll
            for (int ai = 0; ai < 2; ++ai)
#pragma unroll
                for (int m = 0; m < 4; ++m) { bf16* rp = base + (size_t)(row0 + ai * HALF + m * 16) * DM + col0;
#pragma unroll
                    for (int bj = 0; bj < 2; ++bj) { f32x4 v0 = acc[ai][bj][m][0], v1 = acc[ai][bj][m][1];
                        if (act) {
#pragma unroll
                            for (int i = 0; i < 4; ++i) { const float s0 = fast_sigmoid(v0[i]), s1 = fast_sigmoid(v1[i]); v0[i] = act == 1 ? v0[i] * s0 : s0; v1[i] = act == 1 ? v1[i] * s1 : s1; } }
                        u32x4 w; w.x = cvt_pk_bf16(v0[0], v0[1]); w.y = cvt_pk_bf16(v0[2], v0[3]); w.z = cvt_pk_bf16(v1[0], v1[1]); w.w = cvt_pk_bf16(v1[2], v1[3]);
                        *(u32x4*)(rp + bj * HALF) = w; } }
        }
    }
};
struct EpiPlainBf16 {
    static constexpr bool PERM = true;
    bf16* O; int ldc; int pad;
    __device__ __forceinline__ void operator()(Acc& acc, const Unit& u, int wr, int wc, int fr, int fq) const {
        const int row0 = u.pm * BM + wr * 64 + fr, col0 = u.pn * BM + wc * 32 + 8 * fq;
#pragma unroll
        for (int ai = 0; ai < 2; ++ai)
#pragma unroll
            for (int m = 0; m < 4; ++m) { bf16* rp = O + (size_t)(row0 + ai * HALF + m * 16) * ldc + col0;
#pragma unroll
                for (int bj = 0; bj < 2; ++bj) { const f32x4 v0 = acc[ai][bj][m][0], v1 = acc[ai][bj][m][1];
                    u32x4 w; w.x = cvt_pk_bf16(v0[0], v0[1]); w.y = cvt_pk_bf16(v0[2], v0[3]); w.z = cvt_pk_bf16(v1[0], v1[1]); w.w = cvt_pk_bf16(v1[2], v1[3]);
                    *(u32x4*)(rp + bj * HALF) = w; } }
    }
};

__device__ __forceinline__ void unpack8(const u32x4 w, float (&f)[8]) {
    f[0] = __builtin_bit_cast(float, w.x << 16); f[1] = __builtin_bit_cast(float, w.x & 0xffff0000u); f[2] = __builtin_bit_cast(float, w.y << 16); f[3] = __builtin_bit_cast(float, w.y & 0xffff0000u);
    f[4] = __builtin_bit_cast(float, w.z << 16); f[5] = __builtin_bit_cast(float, w.z & 0xffff0000u); f[6] = __builtin_bit_cast(float, w.w << 16); f[7] = __builtin_bit_cast(float, w.w & 0xffff0000u);
}
struct EpiMerged {
    static constexpr bool PERM = true;
    const bf16* GA; const bf16* GB; bf16* O; float* T1;
    __device__ __forceinline__ void operator()(Acc& acc, const Unit& u, int wr, int wc, int fr, int fq) const {
        const int row0 = u.pm * BM + wr * 64 + fr, col0 = u.pn * BM + wc * 32 + 8 * fq;
        const bf16* G = u.keep ? GA : GB;
#pragma unroll
        for (int ai = 0; ai < 2; ++ai)
#pragma unroll
            for (int m = 0; m < 4; ++m) { const size_t off = (size_t)(row0 + ai * HALF + m * 16) * DM + col0;
#pragma unroll
                for (int bj = 0; bj < 2; ++bj) { float g[8]; unpack8(*(const u32x4*)(G + off + bj * HALF), g); f32x4 v0 = acc[ai][bj][m][0], v1 = acc[ai][bj][m][1];
#pragma unroll
                    for (int i = 0; i < 4; ++i) { v0[i] *= g[i]; v1[i] *= g[4 + i]; }
                    float* tp = T1 + off + bj * HALF;
                    if (u.keep) { *(f32x4*)tp = v0; *(f32x4*)(tp + 4) = v1; }
                    else { v0 += *(const f32x4*)tp; v1 += *(const f32x4*)(tp + 4);
                        u32x4 w; w.x = cvt_pk_bf16(v0[0], v0[1]); w.y = cvt_pk_bf16(v0[2], v0[3]); w.z = cvt_pk_bf16(v1[0], v1[1]); w.w = cvt_pk_bf16(v1[2], v1[3]);
                        *(u32x4*)(O + off + bj * HALF) = w; } }
                asm volatile("" ::: "memory"); }
    }
};
struct EpiResidF32 {
    static constexpr bool PERM = false;
    const float* base; float* out;
    __device__ __forceinline__ void operator()(Acc& acc, const Unit& u, int wr, int wc, int fr, int fq) const {
        const int row0 = u.pm * BM + wr * 64 + fr, col0 = u.pn * BM + wc * 32 + 4 * fq;
#pragma unroll
        for (int ai = 0; ai < 2; ++ai)
#pragma unroll
            for (int m = 0; m < 4; ++m) { const size_t off = (size_t)(row0 + ai * HALF + m * 16) * DM + col0;
#pragma unroll
                for (int bj = 0; bj < 2; ++bj)
#pragma unroll
                    for (int n = 0; n < 2; ++n) *(f32x4*)(out + off + bj * HALF + n * 16) = *(const f32x4*)(base + off + bj * HALF + n * 16) + acc[ai][bj][m][n]; }
    }
};
struct EpiPleOut {
    static constexpr bool PERM = false;
    const float* x2; const bf16* pp; float* out;
    __device__ __forceinline__ void operator()(Acc& acc, const Unit& u, int wr, int wc, int fr, int fq) const {
        const int row0 = u.pm * BM + wr * 64 + fr, col0 = u.pn * BM + wc * 32 + 4 * fq;
#pragma unroll
        for (int ai = 0; ai < 2; ++ai)
#pragma unroll
            for (int m = 0; m < 4; ++m) { const size_t off = (size_t)(row0 + ai * HALF + m * 16) * DM + col0;
#pragma unroll
                for (int bj = 0; bj < 2; ++bj)
#pragma unroll
                    for (int n = 0; n < 2; ++n) { const size_t o = off + bj * HALF + n * 16; const u32x2 pw = *(const u32x2*)(pp + o); const f32x4 a = acc[ai][bj][m][n]; f32x4 r = *(const f32x4*)(x2 + o);
                        r[0] += fast_sigmoid(a[0]) * __builtin_bit_cast(float, pw.x << 16); r[1] += fast_sigmoid(a[1]) * __builtin_bit_cast(float, pw.x & 0xffff0000u);
                        r[2] += fast_sigmoid(a[2]) * __builtin_bit_cast(float, pw.y << 16); r[3] += fast_sigmoid(a[3]) * __builtin_bit_cast(float, pw.y & 0xffff0000u);
                        *(f32x4*)(out + o) = r; } }
    }
};

constexpr int MOE_MAXU = 24;
struct MoeRec { int e, mt, pn, nvalid, arow0, pad0, pad1, pad2; };
struct MoeOrder {
    LAS const int* tab;
    unsigned bstride_e, btile;
    int a_dense;
    __device__ __forceinline__ bool next(int i, Unit& u) const {
        const int n = __builtin_amdgcn_readfirstlane(tab[0]); if (i >= n) return false;
        LAS const int* r = tab + 16 + i * 8;
        u.e = __builtin_amdgcn_readfirstlane(r[0]); u.pm = __builtin_amdgcn_readfirstlane(r[1]); u.pn = __builtin_amdgcn_readfirstlane(r[2]); u.nvalid = __builtin_amdgcn_readfirstlane(r[3]);
        const int arow0 = __builtin_amdgcn_readfirstlane(r[4]);
        u.aoff = a_dense ? (unsigned)arow0 * 2048u : 0u; u.boff = (unsigned)u.e * bstride_e + (unsigned)u.pn * btile; u.slot = i; u.keep = arow0; return true;
    }
    __device__ __forceinline__ void gather(const Unit& u, unsigned (&voffA)[2][2]) const {
        LAS const unsigned* g = (LAS const unsigned*)(tab + 256) + u.slot * 256;
#pragma unroll
        for (int i = 0; i < 2; ++i) { int R, C; stage_rc((int)threadIdx.x * 16 + i * 8192, R, C); voffA[0][i] = g[R] + (unsigned)C * 2u; voffA[1][i] = g[R + 128] + (unsigned)C * 2u; }
    }
};
struct EpiMoeGU {
    static constexpr bool PERM = true;
    const float* bias; bf16* act;
    __device__ __forceinline__ void operator()(Acc& acc, const Unit& u, int wr, int wc, int fr, int fq) const {
        const int g0 = u.pn * 128 + wc * 32 + 8 * fq; const float* bg = bias + (size_t)u.e * 2048 + g0;
        const f32x4 bg0 = *(const f32x4*)bg, bg1 = *(const f32x4*)(bg + 4), bu0 = *(const f32x4*)(bg + 1024), bu1 = *(const f32x4*)(bg + 1028);
#pragma unroll
        for (int ai = 0; ai < 2; ++ai)
#pragma unroll
            for (int m = 0; m < 4; ++m) { const int r = ai * HALF + wr * 64 + m * 16 + fr;
                const f32x4 ga = acc[ai][0][m][0] + bg0, gb = acc[ai][0][m][1] + bg1, ua = acc[ai][1][m][0] + bu0, ub = acc[ai][1][m][1] + bu1; float o[8];
#pragma unroll
                for (int i = 0; i < 4; ++i) { const float g1 = fminf(ga[i], SW_LIMIT), g2 = fminf(gb[i], SW_LIMIT); const float u1 = fminf(fmaxf(ua[i], -SW_LIMIT), SW_LIMIT), u2 = fminf(fmaxf(ub[i], -SW_LIMIT), SW_LIMIT);
                    o[i] = (u1 + 1.0f) * (g1 * fast_sigmoid(g1 * SW_ALPHA)); o[4 + i] = (u2 + 1.0f) * (g2 * fast_sigmoid(g2 * SW_ALPHA)); }
                u32x4 w; w.x = cvt_pk_bf16(o[0], o[1]); w.y = cvt_pk_bf16(o[2], o[3]); w.z = cvt_pk_bf16(o[4], o[5]); w.w = cvt_pk_bf16(o[6], o[7]);
                if (r < u.nvalid) *(u32x4*)(act + (size_t)(u.keep + r) * DFF + g0) = w; }
    }
};
struct EpiMoeDown {
    static constexpr bool PERM = true;
    const float* bias; const int* rowlist; const float* roww; bf16* out4;
    __device__ __forceinline__ void operator()(Acc& acc, const Unit& u, int wr, int wc, int fr, int fq) const {
        const int c0 = u.pn * BM + wc * 32 + 8 * fq; const float* bp = bias + (size_t)u.e * DM + c0;
        f32x4 bv[2][2];
#pragma unroll
        for (int bj = 0; bj < 2; ++bj) { bv[bj][0] = *(const f32x4*)(bp + bj * HALF); bv[bj][1] = *(const f32x4*)(bp + bj * HALF + 4); }
#pragma unroll
        for (int ai = 0; ai < 2; ++ai)
#pragma unroll
            for (int m = 0; m < 4; ++m) { const int r = ai * HALF + wr * 64 + m * 16 + fr; const bool ok = r < u.nvalid; const size_t li = (size_t)u.e * NT + (size_t)u.pm * BM + (ok ? r : 0);
                const int ent = rowlist[li]; const float w = roww[li]; bf16* op = out4 + (size_t)ent * DM + c0;
#pragma unroll
                for (int bj = 0; bj < 2; ++bj) { const f32x4 v0 = (acc[ai][bj][m][0] + bv[bj][0]) * w, v1 = (acc[ai][bj][m][1] + bv[bj][1]) * w;
                    u32x4 o; o.x = cvt_pk_bf16(v0[0], v0[1]); o.y = cvt_pk_bf16(v0[2], v0[3]); o.z = cvt_pk_bf16(v1[0], v1[1]); o.w = cvt_pk_bf16(v1[2], v1[3]);
                    if (ok) *(u32x4*)(op + bj * HALF) = o; } }
    }
};
}

struct Frame {
    LAS unsigned char* lds; volatile LAS unsigned* MISC; gu32* ctl; int tid, lane, wave, vcu, G;
};
struct Args { const void* in[21]; float* out; unsigned char* ws; int ph_lo, ph_hi, li, pad; };

template <class RowFn>
__device__ __forceinline__ void p0_transpose_item(const float* W, int ldw, bf16* WT, int ldk, int koff, LAS float* scr, int kb, int nb, int lane, const RowFn& rowfn) {
    const int k0 = 64 * kb, n0 = 32 * nb;
    f32x4 v[8];
#pragma unroll
    for (int i = 0; i < 8; ++i) { const int kk = 8 * i + (lane >> 3); v[i] = *(const GAS f32x4*)(W + (size_t)(k0 + kk) * ldw + n0 + 4 * (lane & 7)); }
#pragma unroll
    for (int i = 0; i < 8; ++i) { const int kk = 8 * i + (lane >> 3); LAS float* d = scr + kk * 33 + 4 * (lane & 7); d[0] = v[i][0]; d[1] = v[i][1]; d[2] = v[i][2]; d[3] = v[i][3]; }
    LDS_WAIT(); asm volatile("" ::: "memory");
    const int c = lane & 7;
#pragma unroll
    for (int j = 0; j < 4; ++j) { const int n = (lane >> 3) + 8 * j; const LAS float* s = scr + (8 * c) * 33 + n;
        u32x4 o; o.x = pk2(s[0 * 33], s[1 * 33]); o.y = pk2(s[2 * 33], s[3 * 33]); o.z = pk2(s[4 * 33], s[5 * 33]); o.w = pk2(s[6 * 33], s[7 * 33]);
        *(GAS u32x4*)(WT + (size_t)rowfn(n0 + n) * ldk + koff + k0 + 8 * c) = o; }
    LDS_WAIT(); asm volatile("" ::: "memory");
}
struct RowId { __device__ __forceinline__ int operator()(int n) const { return n; } };
struct RowWin {
    __device__ __forceinline__ int operator()(int n) const { const int seg = n >> 10; if (seg >= 2) return n; const int c = n & 1023, head = c >> 7, d = c & 127;
        return seg * 1024 + (head >> 1) * 256 + ((d >> 6) << 7) + ((head & 1) << 6) + (d & 63); } };
struct RowWgu {
    __device__ __forceinline__ int operator()(int n) const { const int up = n >> 10, c = n & 1023; return (c >> 7) * 256 + up * 128 + (c & 127); } };

__device__ __forceinline__ void p0_prologue(Frame& F, const Args& a) {
    unsigned char* ws = a.ws;
    LAS float* scr = (LAS float*)(F.lds + RING_OFF + F.wave * 16384);
    const int gw = F.vcu * NWAVES + F.wave, NGW = F.G * NWAVES;
    const float* w_in = (const float*)a.in[4]; const float* w_branch = (const float*)a.in[8]; const float* w_out = (const float*)a.in[9];
    const float* w_gu = (const float*)a.in[13]; const float* w_down = (const float*)a.in[15]; const float* w_pg = (const float*)a.in[18]; const float* w_pp = (const float*)a.in[19];
    constexpr int I_IN = 16 * (INW / 32), I_SQ = 16 * 32, I_PP = 4 * 32, I_GU = 16 * 64, I_DN = 16 * 32;
    constexpr int NITEMS = I_IN + 3 * I_SQ + I_PP + NE * (I_GU + I_DN);
    for (int it = gw; it < NITEMS; it += NGW) {
        int r = it;
        if (r < I_IN) { p0_transpose_item(w_in, INW, (bf16*)(ws + WS_WIN), DM, 0, scr, r / (INW / 32), r % (INW / 32), F.lane, RowWin()); continue; } r -= I_IN;
        if (r < I_SQ) { p0_transpose_item(w_branch, DM, (bf16*)(ws + WS_WB), 2048, 0, scr, r / 32, r % 32, F.lane, RowId()); continue; } r -= I_SQ;
        if (r < I_SQ) { p0_transpose_item(w_out, DM, (bf16*)(ws + WS_WOUT), DM, 0, scr, r / 32, r % 32, F.lane, RowId()); continue; } r -= I_SQ;
        if (r < I_SQ) { p0_transpose_item(w_pg, DM, (bf16*)(ws + WS_WPG), DM, 0, scr, r / 32, r % 32, F.lane, RowId()); continue; } r -= I_SQ;
        if (r < I_PP) { p0_transpose_item(w_pp, DM, (bf16*)(ws + WS_WPP), PLE, 0, scr, r / 32, r % 32, F.lane, RowId()); continue; } r -= I_PP;
        const int e = r / (I_GU + I_DN); r -= e * (I_GU + I_DN);
        if (r < I_GU) p0_transpose_item(w_gu + (size_t)e * DM * 2048, 2048, (bf16*)(ws + WS_WGU) + (size_t)e * 2048 * DM, DM, 0, scr, r / 64, r % 64, F.lane, RowWgu());
        else { r -= I_GU; p0_transpose_item(w_down + (size_t)e * DFF * DM, DM, (bf16*)(ws + WS_WD) + (size_t)e * DM * DFF, DFF, 0, scr, r / 32, r % 32, F.lane, RowId()); }
    }
    { const float* x = (const float*)a.in[0]; const float* g = (const float*)a.in[3]; bf16* H = (bf16*)(ws + WS_H);
      f32x4 gv[4];
#pragma unroll
      for (int j = 0; j < 4; ++j) gv[j] = *(const GAS f32x4*)(g + 4 * F.lane + 256 * j);
      for (int m = gw; m < NT; m += NGW) {
          const GAS f32x4* xr = (const GAS f32x4*)(x + (size_t)m * DM) + F.lane; f32x4 v[4]; float s = 0.f;
#pragma unroll
          for (int j = 0; j < 4; ++j) { v[j] = xr[64 * j]; s += (v[j].x * v[j].x + v[j].y * v[j].y) + (v[j].z * v[j].z + v[j].w * v[j].w); }
          const float rs = rsqrtf(wave_sum(s) * (1.0f / DM) + RMS_EPS);
          GAS u32x2* o8 = (GAS u32x2*)(H + (size_t)m * DM) + F.lane;
#pragma unroll
          for (int j = 0; j < 4; ++j) { u32x2 o; o.x = pk2(v[j].x * rs * gv[j].x, v[j].y * rs * gv[j].y); o.y = pk2(v[j].z * rs * gv[j].z, v[j].w * rs * gv[j].w); o8[64 * j] = o; }
      } }
    { const float* p = (const float*)a.in[1]; bf16* PB = (bf16*)(ws + WS_PB); const int gt = F.vcu * (NWAVES * 64) + F.tid, NGT = F.G * NWAVES * 64;
      for (int i = gt; i < NT * PLE / 8; i += NGT) { const f32x4 a0 = *(const GAS f32x4*)(p + (size_t)i * 8), a1 = *(const GAS f32x4*)(p + (size_t)i * 8 + 4);
          u32x4 o; o.x = pk2(a0.x, a0.y); o.y = pk2(a0.z, a0.w); o.z = pk2(a1.x, a1.y); o.w = pk2(a1.z, a1.w); *(GAS u32x4*)(PB + (size_t)i * 8) = o; }
      const int* pos = (const int*)a.in[2]; float* trig = (float*)(ws + WS_TRIG);
      for (int i = gt; i < NT * 64; i += NGT) { float c, s; rot_cs(pos[i >> 6], i & 63, c, s); { typedef float f32x2_ __attribute__((ext_vector_type(2))); *(GAS f32x2_*)(trig + (size_t)i * 2) = (f32x2_){c, s}; } }
      { const float* gf = (const float*)a.in[10]; const float* wr = (const float*)a.in[11]; float* wrg = (float*)(ws + WS_WRG);
        for (int i = gt; i < DM * NE; i += NGT) wrg[i] = gf[i >> 5] * wr[i]; }
      const float* wp = (const float*)a.in[6]; const float* psc = (const float*)a.in[7]; const float* wb1 = w_branch + (size_t)DM * DM; bf16* WB = (bf16*)(ws + WS_WB);
      for (int i = gt; i < DM * DM / 8; i += NGT) { const int n = (i & 63) + ((i >> 13) << 6), kc = (i >> 6) & 127, k0 = kc * 8, g = k0 >> 8;
          float acc[8];
#pragma unroll
          for (int q = 0; q < 8; ++q) acc[q] = 0.f;
          const float* wpr = wp + ((size_t)g * 256 + (k0 & 255)) * 256;
          for (int j = 0; j < 256; ++j) { const float b = psc[g * 256 + j] * wb1[(size_t)(g * 256 + j) * DM + n];
#pragma unroll
              for (int q = 0; q < 8; ++q) acc[q] = fmaf(wpr[q * 256 + j], b, acc[q]); }
          u32x4 o; o.x = pk2(acc[0], acc[1]); o.y = pk2(acc[2], acc[3]); o.z = pk2(acc[4], acc[5]); o.w = pk2(acc[6], acc[7]);
          *(GAS u32x4*)(WB + (size_t)n * 2048 + 1024 + k0) = o; }
    }
}

__device__ __forceinline__ void moe_build(Frame& F, const unsigned* cnt, const int* rowlist, int ntn, bool gather) {
    LAS int* tab = (LAS int*)(F.lds + LDS_TAB_OFF);
    LAS int* tp = tab + 6400;
    if (F.tid < 64) {
        const int e = F.lane; const int c = e < NE ? (int)cnt[e] : 0; const int tl = (c + 255) >> 8; int it = tl, ic = c;
#pragma unroll
        for (int o = 1; o < 32; o <<= 1) { const int a = __shfl_up(it, o), b = __shfl_up(ic, o); if ((e & 31) >= o) { it += a; ic += b; } }
        if (e < NE) { tp[e + 1] = it; tp[40 + e + 1] = ic; if (e == 0) { tp[0] = 0; tp[40] = 0; } }
    }
    __syncthreads();
    const int total = tp[NE] * ntn;
    if (F.tid < pg8::MOE_MAXU) {
        const int L = F.tid * F.G + F.vcu;
        if (L < total) { const int tix = L / ntn, pn = L % ntn; int e = 0;
            for (int q = 0; q < NE; ++q) if (tp[q + 1] <= tix) e = q + 1;
            const int mt = tix - tp[e], c = tp[40 + e + 1] - tp[40 + e]; int nv = c - mt * 256; nv = nv > 256 ? 256 : nv;
            LAS int* r = tab + 16 + F.tid * 8; r[0] = e; r[1] = mt; r[2] = pn; r[3] = nv; r[4] = tp[40 + e] + mt * 256; }
    }
    if (F.tid == 0) { int n = 0; while (n < pg8::MOE_MAXU && n * F.G + F.vcu < total) ++n; tab[0] = n; }
    __syncthreads();
    if (gather) { const int n = tab[0];
        for (int idx = F.tid; idx < n * 256; idx += NWAVES * 64) { const int sl = idx >> 8, r = idx & 255; LAS const int* rec = tab + 16 + sl * 8; const int e = rec[0], mt = rec[1], nv = rec[3];
            const int rr = mt * 256 + (r < nv ? r : nv - 1); const int ent = rowlist[(size_t)e * NT + rr]; ((LAS unsigned*)(tab + 256))[idx] = (unsigned)(ent >> 2) * 2048u; } }
    __syncthreads();
}

typedef float f32x16 __attribute__((ext_vector_type(16)));
__device__ __forceinline__ void ph_router(Frame& F, const Args& a) {
    unsigned char* ws = a.ws; const float* X1 = (const float*)(ws + WS_X1); bf16* H2 = (bf16*)(ws + WS_H2); const float* WRG = (const float*)(ws + WS_WRG);
    const float* gf = (const float*)a.in[10]; const float* br = (const float*)a.in[12];
    int* ROWLIST = (int*)(ws + WS_ROWLIST); float* ROWW = (float*)(ws + WS_ROWW); unsigned* CNT = (unsigned*)(ws + WS_CTL) + CW_CNT;
    LAS float* rstd = (LAS float*)(F.lds + RING_OFF); LAS float* part = (LAS float*)(F.lds + RING_OFF + 1024);
    LAS unsigned* cntl = (LAS unsigned*)(F.lds + RING_OFF + 1024 + 4 * 64 * 33 * 4); LAS unsigned* lbase = cntl + 32;
    f32x4 gv[4];
#pragma unroll
    for (int j = 0; j < 4; ++j) gv[j] = *(const GAS f32x4*)(gf + 4 * F.lane + 256 * j);
    for (int tile = F.vcu; tile < NT / 64; tile += F.G) {
        const int t0 = tile * 64;
        for (int j = 0; j < 8; ++j) { const int tl = F.wave * 8 + j; const GAS f32x4* xr = (const GAS f32x4*)(X1 + (size_t)(t0 + tl) * DM) + F.lane; f32x4 v[4]; float sq = 0.f;
#pragma unroll
            for (int q = 0; q < 4; ++q) { v[q] = xr[64 * q]; sq += (v[q].x * v[q].x + v[q].y * v[q].y) + (v[q].z * v[q].z + v[q].w * v[q].w); }
            const float rs = rsqrtf(wave_sum(sq) * (1.0f / DM) + RMS_EPS); if (F.lane == 0) rstd[tl] = rs;
            GAS u32x2* o8 = (GAS u32x2*)(H2 + (size_t)(t0 + tl) * DM) + F.lane;
#pragma unroll
            for (int q = 0; q < 4; ++q) { u32x2 o; o.x = pk2(v[q].x * rs * gv[q].x, v[q].y * rs * gv[q].y); o.y = pk2(v[q].z * rs * gv[q].z, v[q].w * rs * gv[q].w); o8[64 * q] = o; } }
        { const int th = F.wave & 1, kq = F.wave >> 1, hh = F.lane >> 5, l31 = F.lane & 31;
          const float* xa = X1 + (size_t)(t0 + 32 * th + l31) * DM + 256 * kq; const float* wb = WRG + (size_t)(256 * kq + hh) * NE + l31;
          f32x16 acc; for (int i = 0; i < 16; ++i) acc[i] = 0.f;
#pragma unroll 4
          for (int s4 = 0; s4 < 64; ++s4) { const f32x4 av = *(const GAS f32x4*)(xa + 4 * s4); const float b0 = wb[(4 * s4) * NE], b1 = wb[(4 * s4 + 2) * NE];
              const float a0 = hh ? av[1] : av[0], a1 = hh ? av[3] : av[2];
              acc = __builtin_amdgcn_mfma_f32_32x32x2f32(a0, b0, acc, 0, 0, 0); acc = __builtin_amdgcn_mfma_f32_32x32x2f32(a1, b1, acc, 0, 0, 0); }
#pragma unroll
          for (int r = 0; r < 16; ++r) { const int row = 32 * th + (r & 3) + 8 * (r >> 2) + 4 * hh; part[(kq * 64 + row) * 33 + l31] = acc[r]; } }
        if (F.tid < 32) cntl[F.tid] = 0u;
        __syncthreads();
        if (F.wave == 0) { const int tl = F.lane; const float rs = rstd[tl];
            float v0 = -INFINITY, v1 = -INFINITY, v2 = -INFINITY, v3 = -INFINITY; int i0 = 0, i1 = 0, i2 = 0, i3 = 0;
#pragma unroll
            for (int e = 0; e < NE; ++e) { const float x = rs * ((part[(0 * 64 + tl) * 33 + e] + part[(1 * 64 + tl) * 33 + e]) + (part[(2 * 64 + tl) * 33 + e] + part[(3 * 64 + tl) * 33 + e])) + br[e];
                const bool c0 = x > v0, c1 = x > v1, c2 = x > v2, c3 = x > v3;
                v3 = c2 ? v2 : (c3 ? x : v3); i3 = c2 ? i2 : (c3 ? e : i3);
                v2 = c1 ? v1 : (c2 ? x : v2); i2 = c1 ? i1 : (c2 ? e : i2);
                v1 = c0 ? v0 : (c1 ? x : v1); i1 = c0 ? i0 : (c1 ? e : i1);
                v0 = c0 ? x : v0; i0 = c0 ? e : i0; }
            const float e1 = __expf(v1 - v0), e2 = __expf(v2 - v0), e3 = __expf(v3 - v0); const float inv = 1.0f / (1.0f + e1 + e2 + e3);
            const unsigned r0 = __hip_atomic_fetch_add(cntl + i0, 1u, __ATOMIC_RELAXED, __HIP_MEMORY_SCOPE_WORKGROUP), r1 = __hip_atomic_fetch_add(cntl + i1, 1u, __ATOMIC_RELAXED, __HIP_MEMORY_SCOPE_WORKGROUP);
            const unsigned r2 = __hip_atomic_fetch_add(cntl + i2, 1u, __ATOMIC_RELAXED, __HIP_MEMORY_SCOPE_WORKGROUP), r3 = __hip_atomic_fetch_add(cntl + i3, 1u, __ATOMIC_RELAXED, __HIP_MEMORY_SCOPE_WORKGROUP);
            LDS_WAIT(); asm volatile("" ::: "memory");
            if (F.lane < 32) { const unsigned n = cntl[F.lane]; lbase[F.lane] = n ? __hip_atomic_fetch_add(CNT + F.lane, n, RLX_AGENT) : 0u; }
            LDS_WAIT(); asm volatile("" ::: "memory");
            const int ent = (t0 + tl) * 4;
            { const size_t q0 = (size_t)i0 * NT + lbase[i0] + r0, q1 = (size_t)i1 * NT + lbase[i1] + r1, q2 = (size_t)i2 * NT + lbase[i2] + r2, q3 = (size_t)i3 * NT + lbase[i3] + r3;
              ROWLIST[q0] = ent; ROWLIST[q1] = ent + 1; ROWLIST[q2] = ent + 2; ROWLIST[q3] = ent + 3; ROWW[q0] = inv; ROWW[q1] = e1 * inv; ROWW[q2] = e2 * inv; ROWW[q3] = e3 * inv; }
        }
        __syncthreads();
    }
}
typedef short s16x4 __attribute__((ext_vector_type(4)));
__device__ __forceinline__ s16x4 tr_read(LAS const unsigned char* p) { return __builtin_bit_cast(s16x4, __builtin_amdgcn_ds_read_tr16_b64_v4i16((LAS s16x4*)p)); }
__device__ __forceinline__ bf16x8 cat8(s16x4 lo, s16x4 hi) { return __builtin_shufflevector(lo, hi, 0, 1, 2, 3, 4, 5, 6, 7); }
__device__ __forceinline__ int crow(int reg, int h) { return (reg & 3) + 8 * (reg >> 2) + 4 * h; }
#define MFMA32(a, b, c) __builtin_amdgcn_mfma_f32_32x32x16_bf16((a), (b), (c), 0, 0, 0)
constexpr int KP = 272, VP = 320;
__device__ __forceinline__ float log2_gamma(int h) { return log1pf(-exp2f(-5.0f - (float)h)) * 1.4426950408889634f; }

__device__ __forceinline__ void ph_kv_pool(Frame& F, const Args& a) {
    unsigned char* ws = a.ws; const bf16* K = (const bf16*)(ws + WS_K); const bf16* V = (const bf16*)(ws + WS_V); float* KVT = (float*)(ws + WS_KVT);
    LAS unsigned char* Ks = F.lds + RING_OFF; LAS unsigned char* Vs = F.lds + RING_OFF + 128 * VP;
    const int lane = F.lane, hh = lane >> 5, l31 = lane & 31, q4 = (lane & 15) >> 2, p4 = lane & 3, blk = (lane >> 4) & 1;
    for (int task = F.vcu; task < NB * NH * NCH; task += F.G) {
        const int bh = task >> 6, n = task & 63, b = bh >> 3, h = bh & 7; const float lg2 = log2_gamma(h);
        const size_t row0 = (size_t)b * SEQ + (size_t)n * CH; const int col0 = h * DH;
#pragma unroll
        for (int i = 0; i < 4; ++i) { const int idx = F.tid + 512 * i, r = idx >> 4, c = idx & 15;
            const u32x4 kv = *(const GAS u32x4*)(K + (row0 + r) * DM + col0 + c * 8); const u32x4 vv = *(const GAS u32x4*)(V + (row0 + r) * DM + col0 + c * 8);
            float f[8]; pg8::unpack8(vv, f); const float z = __builtin_amdgcn_exp2f(lg2 * (float)(CH - 1 - r));
            u32x4 vz; vz.x = cvt_pk_bf16(f[0] * z, f[1] * z); vz.y = cvt_pk_bf16(f[2] * z, f[3] * z); vz.z = cvt_pk_bf16(f[4] * z, f[5] * z); vz.w = cvt_pk_bf16(f[6] * z, f[7] * z);
            *(LAS u32x4*)(Ks + r * VP + c * 16) = kv; *(LAS u32x4*)(Vs + r * VP + c * 16) = vz; }
        __syncthreads();
        { const int eb = F.wave >> 1, db0 = 2 * (F.wave & 1);
          f32x16 acc0, acc1; for (int i = 0; i < 16; ++i) { acc0[i] = 0.f; acc1[i] = 0.f; }
#pragma unroll
          for (int s = 0; s < 8; ++s) { const int rb = (16 * s + 8 * hh + q4) * VP; const int cb = (16 * blk + 4 * p4) * 2;
              const bf16x8 af = cat8(tr_read(Vs + rb + eb * 64 + cb), tr_read(Vs + rb + 4 * VP + eb * 64 + cb));
              const bf16x8 b0 = cat8(tr_read(Ks + rb + db0 * 64 + cb), tr_read(Ks + rb + 4 * VP + db0 * 64 + cb));
              const bf16x8 b1 = cat8(tr_read(Ks + rb + (db0 + 1) * 64 + cb), tr_read(Ks + rb + 4 * VP + (db0 + 1) * 64 + cb));
              acc0 = MFMA32(af, b0, acc0); acc1 = MFMA32(af, b1, acc1); }
          float* o = KVT + ((size_t)bh * NCH + n) * DH * DH;
#pragma unroll
          for (int r = 0; r < 16; ++r) { const int e = eb * 32 + crow(r, hh); o[(size_t)e * DH + db0 * 32 + l31] = acc0[r]; o[(size_t)e * DH + (db0 + 1) * 32 + l31] = acc1[r]; } }
        __syncthreads();
    }
    { const bf16* U = (const bf16*)(ws + WS_U); bf16* YM = (bf16*)(ws + WS_YM); const int gt = F.vcu * (NWAVES * 64) + F.tid, NGT = F.G * NWAVES * 64;
      for (int it = gt; it < NT * 128; it += NGT) { const int t = it >> 7, cg = it & 127, c0 = cg * 8, w = 2 << (cg >> 5), tt = t & (SEQ - 1); const int cnt = tt + 1 < w ? tt + 1 : w;
          float sum[8], own[8]; pg8::unpack8(*(const GAS u32x4*)(U + (size_t)t * DM + c0), own);
#pragma unroll
          for (int i = 0; i < 8; ++i) sum[i] = own[i];
          for (int k = 1; k < cnt; ++k) { float f[8]; pg8::unpack8(*(const GAS u32x4*)(U + (size_t)(t - k) * DM + c0), f);
#pragma unroll
              for (int i = 0; i < 8; ++i) sum[i] += f[i]; }
          const float ic = 1.0f / (float)cnt; u32x4 o;
          o.x = cvt_pk_bf16(sum[0] * ic - own[0], sum[1] * ic - own[1]); o.y = cvt_pk_bf16(sum[2] * ic - own[2], sum[3] * ic - own[3]);
          o.z = cvt_pk_bf16(sum[4] * ic - own[4], sum[5] * ic - own[5]); o.w = cvt_pk_bf16(sum[6] * ic - own[6], sum[7] * ic - own[7]);
          *(GAS u32x4*)(YM + (size_t)t * 2048 + 1024 + c0) = o; } }
}
__device__ __forceinline__ void ph_scan(Frame& F, const Args& a) {
    unsigned char* ws = a.ws; const float* KVT = (const float*)(ws + WS_KVT); bf16* PREVT = (bf16*)(ws + WS_PREVT);
    const int gt = F.vcu * (NWAVES * 64) + F.tid, NGT = F.G * NWAVES * 64;
    for (int idx = gt; idx < NB * NH * DH * DH / 2; idx += NGT) { const int bh = idx >> 13, ed = (idx & 8191) * 2; const float dec = __builtin_amdgcn_exp2f(log2_gamma(bh & 7) * (float)CH);
        float s0 = 0.f, s1 = 0.f; const size_t base = (size_t)bh * NCH * DH * DH + ed;
#pragma unroll 8
        for (int n = 0; n < NCH; ++n) { const size_t o = base + (size_t)n * DH * DH; const f32x2_t kv = *(const GAS f32x2_t*)(KVT + o);
            *(GAS unsigned*)(PREVT + o) = cvt_pk_bf16(s0, s1); s0 = s0 * dec + kv.x; s1 = s1 * dec + kv.y; } }
}
__device__ __forceinline__ void ph_retout(Frame& F, const Args& a) {
    unsigned char* ws = a.ws; const bf16* Q = (const bf16*)(ws + WS_Q); const bf16* K = (const bf16*)(ws + WS_K); const bf16* V = (const bf16*)(ws + WS_V);
    const bf16* PREVT = (const bf16*)(ws + WS_PREVT); const bf16* SG = (const bf16*)(ws + WS_SG); const float* gn = (const float*)a.in[5]; bf16* YM = (bf16*)(ws + WS_YM);
    LAS unsigned char* Ks = F.lds + RING_OFF; LAS unsigned char* Vs = Ks + 128 * KP; LAS float* stat = (LAS float*)(Vs + 128 * VP);
    LAS unsigned char* stg = (LAS unsigned char*)(stat + 512) + F.wave * (32 * 144);
    const int lane = F.lane, hh = lane >> 5, l31 = lane & 31, q4 = (lane & 15) >> 2, p4 = lane & 3, blk = (lane >> 4) & 1;
    const int ib = F.wave & 3, eh = F.wave >> 2, e0 = eh * 64;
    for (int task = F.vcu; task < NB * NH * NCH; task += F.G) {
        const int bh = task >> 6, n = task & 63, b = bh >> 3, h = bh & 7; const float lg2 = log2_gamma(h);
        const size_t row0 = (size_t)b * SEQ + (size_t)n * CH; const int col0 = h * DH;
#pragma unroll
        for (int i = 0; i < 4; ++i) { const int idx = F.tid + 512 * i, r = idx >> 4, c = idx & 15;
            *(LAS u32x4*)(Ks + r * KP + c * 16) = *(const GAS u32x4*)(K + (row0 + r) * DM + col0 + c * 8);
            *(LAS u32x4*)(Vs + r * VP + c * 16) = *(const GAS u32x4*)(V + (row0 + r) * DM + col0 + c * 8); }
        bf16x8 qf[8];
#pragma unroll
        for (int s = 0; s < 8; ++s) qf[s] = *(const GAS bf16x8*)(Q + (row0 + ib * 32 + l31) * DM + col0 + 16 * s + 8 * hh);
        f32x16 acc0, acc1; for (int i = 0; i < 16; ++i) { acc0[i] = 0.f; acc1[i] = 0.f; }
        { const bf16* pt = PREVT + (((size_t)bh * NCH + n) * DH + e0 + l31) * DH + 8 * hh;
#pragma unroll
          for (int s = 0; s < 8; ++s) { const bf16x8 b0 = *(const GAS bf16x8*)(pt + 16 * s), b1 = *(const GAS bf16x8*)(pt + 32 * DH + 16 * s);
              acc0 = MFMA32(qf[s], b0, acc0); acc1 = MFMA32(qf[s], b1, acc1); }
#pragma unroll
          for (int r = 0; r < 16; ++r) { const float xi = __builtin_amdgcn_exp2f(lg2 * (float)(ib * 32 + crow(r, hh) + 1)); acc0[r] *= xi; acc1[r] *= xi; } }
        __syncthreads();
        for (int jb = 0; jb <= ib; ++jb) {
            f32x16 st; for (int i = 0; i < 16; ++i) st[i] = 0.f;
#pragma unroll
            for (int s = 0; s < 8; ++s) { const bf16x8 ka = *(const LAS bf16x8*)(Ks + (jb * 32 + l31) * KP + (16 * s + 8 * hh) * 2); st = MFMA32(ka, qf[s], st); }
#pragma unroll
            for (int r = 0; r < 16; ++r) { const int dl = (ib - jb) * 32 + l31 - crow(r, hh); st[r] = dl >= 0 ? st[r] * __builtin_amdgcn_exp2f(lg2 * (float)dl) : 0.f; }
#pragma unroll
            for (int s2 = 0; s2 < 2; ++s2) { u32x4 pw; pw.x = cvt_pk_bf16(st[8 * s2], st[8 * s2 + 1]); pw.y = cvt_pk_bf16(st[8 * s2 + 2], st[8 * s2 + 3]); pw.z = cvt_pk_bf16(st[8 * s2 + 4], st[8 * s2 + 5]); pw.w = cvt_pk_bf16(st[8 * s2 + 6], st[8 * s2 + 7]);
                const bf16x8 pa = __builtin_bit_cast(bf16x8, pw); const int rb = (jb * 32 + 16 * s2 + 4 * hh + q4) * VP; const int cb = (e0 + 16 * blk + 4 * p4) * 2;
                const bf16x8 v0 = cat8(tr_read(Vs + rb + cb), tr_read(Vs + rb + 8 * VP + cb)); const bf16x8 v1 = cat8(tr_read(Vs + rb + cb + 64), tr_read(Vs + rb + 8 * VP + cb + 64));
                acc0 = MFMA32(pa, v0, acc0); acc1 = MFMA32(pa, v1, acc1); }
        }
        float mw[16], m2[16];
#pragma unroll
        for (int r = 0; r < 16; ++r) { float sm = acc0[r] + acc1[r];
#pragma unroll
            for (int o = 1; o < 32; o <<= 1) sm += __shfl_xor(sm, o);
            mw[r] = sm * (1.0f / 64.0f); const float d0 = acc0[r] - mw[r], d1 = acc1[r] - mw[r]; float qq = d0 * d0 + d1 * d1;
#pragma unroll
            for (int o = 1; o < 32; o <<= 1) qq += __shfl_xor(qq, o);
            m2[r] = qq; if (l31 == 0) { LAS float* sp = stat + ((ib * 2 + eh) * 32 + crow(r, hh)) * 2; sp[0] = mw[r]; sp[1] = qq; } }
        __syncthreads();
#pragma unroll
        for (int r = 0; r < 16; ++r) { const LAS float* sp = stat + ((ib * 2 + (eh ^ 1)) * 32 + crow(r, hh)) * 2; const float mo = sp[0], qo = sp[1];
            const float mean = 0.5f * (mw[r] + mo), dm = mw[r] - mo; const float var = (m2[r] + qo + 32.0f * dm * dm) * (1.0f / 128.0f); const float rs = rsqrtf(var + GN_EPS);
            const float y0 = (acc0[r] - mean) * rs, y1 = (acc1[r] - mean) * rs;
            *(LAS unsigned short*)(stg + crow(r, hh) * 144 + l31 * 2) = (unsigned short)(cvt_pk_bf16(y0, 0.f) & 0xffffu); *(LAS unsigned short*)(stg + crow(r, hh) * 144 + (32 + l31) * 2) = (unsigned short)(cvt_pk_bf16(y1, 0.f) & 0xffffu); }
        LDS_WAIT(); asm volatile("" ::: "memory");
#pragma unroll
        for (int i = 0; i < 4; ++i) { const int idx = lane + 64 * i, rr = idx >> 3, ch = idx & 7; float y[8], g[8];
            pg8::unpack8(*(const LAS u32x4*)(stg + rr * 144 + ch * 16), y); const size_t t = row0 + ib * 32 + rr; const int cc = col0 + e0 + ch * 8;
            pg8::unpack8(*(const GAS u32x4*)(SG + t * DM + cc), g); const f32x4 n0 = *(const GAS f32x4*)(gn + cc), n1 = *(const GAS f32x4*)(gn + cc + 4);
            u32x4 o; o.x = cvt_pk_bf16(y[0] * n0[0] * g[0], y[1] * n0[1] * g[1]); o.y = cvt_pk_bf16(y[2] * n0[2] * g[2], y[3] * n0[3] * g[3]);
            o.z = cvt_pk_bf16(y[4] * n1[0] * g[4], y[5] * n1[1] * g[5]); o.w = cvt_pk_bf16(y[6] * n1[2] * g[6], y[7] * n1[3] * g[7]);
            *(GAS u32x4*)(YM + t * 2048 + cc) = o; }
        __syncthreads();
    }
}

__device__ __forceinline__ void ph_combine(Frame& F, const Args& a) {
    unsigned char* ws = a.ws; const float* X1 = (const float*)(ws + WS_X1); const bf16* OUT4 = (const bf16*)(ws + WS_OUT4); float* X2 = (float*)(ws + WS_X2); bf16* H3 = (bf16*)(ws + WS_H3);
    const float* g = (const float*)a.in[17]; const int gw = F.vcu * NWAVES + F.wave, NGW = F.G * NWAVES;
    f32x4 gv[4];
#pragma unroll
    for (int j = 0; j < 4; ++j) gv[j] = *(const GAS f32x4*)(g + 4 * F.lane + 256 * j);
    for (int m = gw; m < NT; m += NGW) {
        const GAS f32x4* xr = (const GAS f32x4*)(X1 + (size_t)m * DM) + F.lane; f32x4 v[4]; float sq = 0.f;
#pragma unroll
        for (int j = 0; j < 4; ++j) v[j] = xr[64 * j];
#pragma unroll
        for (int k = 0; k < 4; ++k) { const GAS u32x2* orow = (const GAS u32x2*)(OUT4 + ((size_t)m * 4 + k) * DM) + F.lane;
#pragma unroll
            for (int j = 0; j < 4; ++j) { const u32x2 w = orow[64 * j]; v[j].x += __builtin_bit_cast(float, w.x << 16); v[j].y += __builtin_bit_cast(float, w.x & 0xffff0000u); v[j].z += __builtin_bit_cast(float, w.y << 16); v[j].w += __builtin_bit_cast(float, w.y & 0xffff0000u); } }
        GAS f32x4* x2r = (GAS f32x4*)(X2 + (size_t)m * DM) + F.lane;
#pragma unroll
        for (int j = 0; j < 4; ++j) { x2r[64 * j] = v[j]; sq += (v[j].x * v[j].x + v[j].y * v[j].y) + (v[j].z * v[j].z + v[j].w * v[j].w); }
        const float rs = rsqrtf(wave_sum(sq) * (1.0f / DM) + RMS_EPS);
        GAS u32x2* o8 = (GAS u32x2*)(H3 + (size_t)m * DM) + F.lane;
#pragma unroll
        for (int j = 0; j < 4; ++j) { u32x2 o; o.x = pk2(v[j].x * rs * gv[j].x, v[j].y * rs * gv[j].y); o.y = pk2(v[j].z * rs * gv[j].z, v[j].w * rs * gv[j].w); o8[64 * j] = o; }
    }
}
__device__ __forceinline__ void ph_final(Frame& F, const Args& a) {
    const float* g = (const float*)a.in[20]; const int gw = F.vcu * NWAVES + F.wave, NGW = F.G * NWAVES;
    f32x4 gv[4];
#pragma unroll
    for (int j = 0; j < 4; ++j) gv[j] = *(const GAS f32x4*)(g + 4 * F.lane + 256 * j);
    for (int m = gw; m < NT; m += NGW) {
        GAS f32x4* xr = (GAS f32x4*)(a.out + (size_t)m * DM) + F.lane; f32x4 v[4]; float sq = 0.f;
#pragma unroll
        for (int j = 0; j < 4; ++j) { v[j] = xr[64 * j]; sq += (v[j].x * v[j].x + v[j].y * v[j].y) + (v[j].z * v[j].z + v[j].w * v[j].w); }
        const float rs = rsqrtf(wave_sum(sq) * (1.0f / DM) + RMS_EPS);
#pragma unroll
        for (int j = 0; j < 4; ++j) xr[64 * j] = v[j] * rs * gv[j];
    }
}

__global__ void __launch_bounds__(NWAVES * 64, 2) fused_fwd(Args args) {
    extern __shared__ __attribute__((aligned(16))) unsigned char lds[];
    Frame F;
    F.lds = (LAS unsigned char*)lds; F.MISC = (volatile LAS unsigned*)(F.lds + MISC_OFF);
    F.tid = threadIdx.x; F.lane = F.tid & 63; F.wave = __builtin_amdgcn_readfirstlane(F.tid >> 6);
    F.G = gridDim.x; { const int bx = blockIdx.x; F.vcu = (F.G % 8 == 0) ? (bx % 8) * (F.G / 8) + bx / 8 : bx; }
    unsigned char* ws = args.ws;
    F.ctl = (gu32*)(ws + WS_CTL);
    for (int u = F.tid; u < 256; u += NWAVES * 64) ((LAS unsigned*)(F.lds + LDSCTL_OFF))[u] = 0u;
    __syncthreads();
    XcdBarrier bar = xcd_barrier_post((unsigned*)(F.ctl + CW_BAR) + args.li * XCD_BAR_WORDS, F.MISC + 8);
    const int lo = args.ph_lo, hi = args.ph_hi;
#define IN(k) (lo <= (k) && (k) < hi)
#define SEAM(k) do { if (IN(k) && IN((k) + 1)) xcd_barrier(bar); } while (0)
    if (IN(0)) { p0_prologue(F, args); }
    SEAM(0);
    if (IN(1)) {
        { pg8::StaticOrder S; S.init(NT, INW, DM, F.G, (int)blockIdx.x);
          pg8::EpiIn E{(bf16*)(ws + WS_Q), (const float*)(ws + WS_TRIG)};
          pg8::gemm_phase<pg8::EpiIn, pg8::StaticOrder, true, false>(F.lds + RING_OFF, DM, DM, DM, (const char*)(ws + WS_H), (const char*)(ws + WS_WIN), S, E); }
        { pg8::StaticOrder S; S.init(NT, DM, PLE, F.G, (int)blockIdx.x);
          pg8::EpiPlainBf16 E{(bf16*)(ws + WS_PP), DM, 0};
          pg8::gemm_phase<pg8::EpiPlainBf16, pg8::StaticOrder, false, false>(F.lds + RING_OFF, PLE, PLE, PLE, (const char*)(ws + WS_PB), (const char*)(ws + WS_WPP), S, E); }
    }
    SEAM(1);
    if (IN(2)) ph_kv_pool(F, args);
    SEAM(2);
    if (IN(3)) ph_scan(F, args);
    SEAM(3);
    if (IN(4)) ph_retout(F, args);
    SEAM(4);
#ifndef SKIP5
    if (IN(5)) {
        pg8::TwoPartOrder S; S.base.init(NT, DM, DM, F.G, (int)blockIdx.x);
        pg8::EpiMerged E{(const bf16*)(ws + WS_GA), (const bf16*)(ws + WS_GB), (bf16*)(ws + WS_MERGED), (float*)(ws + WS_X2)};
        pg8::gemm_phase<pg8::EpiMerged, pg8::TwoPartOrder, false, false>(F.lds + RING_OFF, DM, 2048, 2048, (const char*)(ws + WS_YM), (const char*)(ws + WS_WB), S, E);
    }
#endif
    SEAM(5);
#ifndef SKIP6
    if (IN(6)) {
        pg8::StaticOrder S; S.init(NT, DM, DM, F.G, (int)blockIdx.x);
        pg8::EpiResidF32 E{(const float*)args.in[0], (float*)(ws + WS_X1)};
        pg8::gemm_phase<pg8::EpiResidF32, pg8::StaticOrder, false, false>(F.lds + RING_OFF, DM, DM, DM, (const char*)(ws + WS_MERGED), (const char*)(ws + WS_WOUT), S, E);
    }
#endif
    SEAM(6);
    if (IN(7)) ph_router(F, args);
    SEAM(7);
    if (IN(8)) {
        const unsigned* CNT = (const unsigned*)(ws + WS_CTL) + CW_CNT;
        moe_build(F, CNT, (const int*)(ws + WS_ROWLIST), 8, true);
        pg8::MoeOrder S{(LAS const int*)(F.lds + LDS_TAB_OFF), 2048u * 1024u * 2u, 256u * 1024u * 2u, 0};
        pg8::EpiMoeGU E{(const float*)args.in[14], (bf16*)(ws + WS_ACT)};
        pg8::gemm_phase<pg8::EpiMoeGU, pg8::MoeOrder, true, true>(F.lds + RING_OFF, DM, DM, DM, (const char*)(ws + WS_H2), (const char*)(ws + WS_WGU), S, E);
    }
    SEAM(8);
    if (IN(9)) {
        const unsigned* CNT = (const unsigned*)(ws + WS_CTL) + CW_CNT;
        moe_build(F, CNT, (const int*)(ws + WS_ROWLIST), 4, false);
        pg8::MoeOrder S{(LAS const int*)(F.lds + LDS_TAB_OFF), 1024u * 1024u * 2u, 256u * 1024u * 2u, 1};
        pg8::EpiMoeDown E{(const float*)args.in[16], (const int*)(ws + WS_ROWLIST), (const float*)(ws + WS_ROWW), (bf16*)(ws + WS_OUT4)};
        pg8::gemm_phase<pg8::EpiMoeDown, pg8::MoeOrder, true, false>(F.lds + RING_OFF, DFF, DFF, DFF, (const char*)(ws + WS_ACT), (const char*)(ws + WS_WD), S, E);
    }
    SEAM(9);
    if (IN(10)) ph_combine(F, args);
    SEAM(10);
#ifndef SKIP11
    if (IN(11)) {
        pg8::StaticOrder S; S.init(NT, DM, DM, F.G, (int)blockIdx.x);
        pg8::EpiPleOut E{(const float*)(ws + WS_X2), (const bf16*)(ws + WS_PP), args.out};
        pg8::gemm_phase<pg8::EpiPleOut, pg8::StaticOrder, false, false>(F.lds + RING_OFF, DM, DM, DM, (const char*)(ws + WS_H3), (const char*)(ws + WS_WPG), S, E);
    }
#endif
    SEAM(11);
    if (IN(12)) ph_final(F, args);
#undef IN
#undef SEAM
}

static int fused_grid() {
    static int grid = 0;
    if (grid == 0) {
        int dev = 0, cus = 0;
        if (hipGetDevice(&dev) != hipSuccess || hipDeviceGetAttribute(&cus, hipDeviceAttributeMultiprocessorCount, dev) != hipSuccess) { grid = -1; return grid; }
        if (hipFuncSetAttribute((const void*)fused_fwd, hipFuncAttributeMaxDynamicSharedMemorySize, LDS_BYTES) != hipSuccess) { fprintf(stderr, "hipFuncSetAttribute failed\n"); grid = -1; return grid; }
        (void)hipGetLastError();
        grid = cus;
    }
    return grid;
}
static void launch_fused(void* const* d_in, float* out, unsigned char* ws, int lo, int hi, int li, hipStream_t st) {
    const int grid = fused_grid(); if (grid <= 0) return;
    Args a; memset(&a, 0, sizeof(a));
    for (int i = 0; i < 21; ++i) a.in[i] = d_in[i];
    a.out = out; a.ws = ws; a.ph_lo = lo; a.ph_hi = hi; a.li = li;
    hipLaunchKernelGGL(fused_fwd, dim3(grid), dim3(NWAVES * 64), LDS_BYTES, st, a);
}

extern "C" void kernel_launch(void* const* d_in, const int* in_sizes, int n_in, void* d_out, int out_size, void* d_ws, size_t ws_size, hipStream_t stream) {
    if (n_in != 21 || out_size != NT * DM || ws_size < WS_END) { fprintf(stderr, "kernel_launch: unexpected shapes (n_in %d out %d ws %zu)\n", n_in, out_size, ws_size); return; }
    (void)in_sizes;
    (void)hipMemsetAsync((char*)d_ws + WS_CTL, 0, CTL_ZERO_BYTES, stream);
#if MK_NAIVE
    launch_fused(d_in, (float*)d_out, (unsigned char*)d_ws, 0, 13, 0, stream);
#endif
}
```

```cpp
#include <hip/hip_runtime.h>
#include <cstdio>
#include <cstdint>
#include <cstring>

constexpr int DM = 1024, NB = 2, SEQ = 8192, NT = NB * SEQ;
constexpr int NH = 8, DH = 128, CH = 128, NCH = SEQ / CH;
constexpr int INW = 7168;
constexpr int NE = 32, TOPK = 4, DFF = 1024;
constexpr int PLE = 256;
constexpr float RMS_EPS = 1e-6f, GN_EPS = 1e-5f;
constexpr float SW_ALPHA = 1.702f, SW_LIMIT = 7.0f;

constexpr size_t MiB = 1u << 20;
constexpr size_t WS_CTL = 0, CTL_ZERO_BYTES = 1 * MiB;
constexpr size_t WS_TOPE = 1 * MiB, WS_TOPW = WS_TOPE + 256 * 1024, WS_ROWLIST = 2 * MiB, WS_ROWW = 4 * MiB;
constexpr size_t WS_TRIG = 8 * MiB;
constexpr size_t WS_WIN = 16 * MiB, WS_WB = 30 * MiB, WS_WOUT = 34 * MiB, WS_WPG = 36 * MiB, WS_WPP = 38 * MiB;
constexpr size_t WS_WRG = 39 * MiB;
constexpr size_t WS_WGU = 40 * MiB, WS_WD = 168 * MiB;
constexpr size_t WS_H = 232 * MiB, WS_PB = 264 * MiB, WS_PP = 272 * MiB;
constexpr size_t WS_Q = 304 * MiB, WS_K = 336 * MiB, WS_V = 368 * MiB, WS_SG = 400 * MiB, WS_U = 432 * MiB, WS_GA = 464 * MiB, WS_GB = 496 * MiB;
constexpr size_t WS_KVT = 528 * MiB, WS_PREVT = 592 * MiB, WS_YM = 624 * MiB, WS_MERGED = 688 * MiB;
constexpr size_t WS_X1 = 720 * MiB, WS_H2 = 784 * MiB, WS_X2 = 816 * MiB, WS_H3 = 880 * MiB, WS_END = 912 * MiB;
constexpr size_t WS_ACT = WS_Q;
constexpr size_t WS_OUT4 = WS_GA;
constexpr size_t WS_TMPA = WS_X1, WS_TMPB = WS_X2;
constexpr int CW_CNT = 1024;

typedef unsigned short bf16;
typedef float f32x4 __attribute__((ext_vector_type(4)));
typedef unsigned u32x4 __attribute__((ext_vector_type(4)));
typedef unsigned u32x2 __attribute__((ext_vector_type(2)));

__device__ __forceinline__ unsigned f2bf(float f) { unsigned u = __builtin_bit_cast(unsigned, f); return (u + 0x7fffu + ((u >> 16) & 1u)) >> 16; }
__device__ __forceinline__ float bf2f(unsigned b) { return __builtin_bit_cast(float, (b & 0xffffu) << 16); }
__device__ __forceinline__ float wave_sum(float v) {
#pragma unroll
    for (int o = 1; o < 64; o <<= 1) v += __shfl_xor(v, o);
    return v;
}
__device__ __forceinline__ float sigmoidf_(float x) { return 1.0f / (1.0f + __expf(-x)); }
__device__ __forceinline__ float log_gamma_h(int h) { return log1pf(-exp2f(-5.0f - (float)h)); }

__device__ __forceinline__ void rot_cs(int pos, int d, float& c, float& s) {
    const double inv = exp2(-(double)d * (13.287712379549449 / 64.0));
    const double a = (double)pos * inv;
    const double n = rint(a * 0.15915494309189535);
    const double r = fma(-n, 6.283185307179586, a) - n * 2.4492935982947064e-16;
    c = (float)cos(r); s = (float)sin(r);
}

#ifndef MK_NAIVE
#define MK_NAIVE 0
#endif
#define REP_LO 99
#define REP_HI 99
#define EXTRA_LO 99
#define EXTRA_HI 99

#if MK_NAIVE
namespace nv {
__global__ void __launch_bounds__(256) rmsnorm_rows(const float* x, const float* g, bf16* ob, float* of, int M) {
    const int row = blockIdx.x * 4 + (threadIdx.x >> 6), lane = threadIdx.x & 63; if (row >= M) return;
    const float* xr = x + (size_t)row * DM; float v[16]; float s = 0.f;
#pragma unroll
    for (int j = 0; j < 16; ++j) { v[j] = xr[lane + 64 * j]; s += v[j] * v[j]; }
    const float rs = rsqrtf(wave_sum(s) * (1.0f / DM) + RMS_EPS);
#pragma unroll
    for (int j = 0; j < 16; ++j) { const float o = v[j] * rs * g[lane + 64 * j]; if (ob) ob[(size_t)row * DM + lane + 64 * j] = (bf16)f2bf(o); if (of) of[(size_t)row * DM + lane + 64 * j] = o; }
}
template <typename AT> __device__ __forceinline__ float lda_(const AT* p);
template <> __device__ __forceinline__ float lda_<float>(const float* p) { return *p; }
template <> __device__ __forceinline__ float lda_<bf16>(const bf16* p) { return bf2f(*p); }

template <class Epi> struct GArgs { const void* A; const int* rowmap; const unsigned* cntp; const float* W; unsigned long long wstride; int lda, rowshift, M, ldw, K, pad; Epi epi; };
template <class Epi, typename AT>
__global__ void __launch_bounds__(256) gemm(GArgs<Epi> ga) {
    const AT* A = (const AT*)ga.A; const int lda = ga.lda; const int* rowmap = ga.rowmap; const int rowshift = ga.rowshift; const unsigned* cntp = ga.cntp; const int M = ga.M;
    const float* W = ga.W; const int ldw = ga.ldw; const size_t wstride = ga.wstride; const int K = ga.K; const Epi epi = ga.epi;
    const int z = blockIdx.z; const int Mv = cntp ? (int)cntp[z] : M;
    const int r0 = blockIdx.y * 16; if (r0 >= Mv) return;
    const int p = blockIdx.x * 256 + threadIdx.x; int n0, n1; epi.cols(p, n0, n1);
    const float* Wz = W + (size_t)z * wstride;
    const AT* Ar[16];
#pragma unroll
    for (int r = 0; r < 16; ++r) { int rr = r0 + r; if (rr >= Mv) rr = Mv - 1; const int arow = rowmap ? (rowmap[(size_t)z * NT + rr] >> rowshift) : rr; Ar[r] = A + (size_t)arow * lda; }
    float acc0[16], acc1[16];
#pragma unroll
    for (int r = 0; r < 16; ++r) { acc0[r] = 0.f; acc1[r] = 0.f; }
    for (int k = 0; k < K; ++k) {
        const float b0 = Wz[(size_t)k * ldw + n0]; const float b1 = n1 >= 0 ? Wz[(size_t)k * ldw + n1] : 0.f;
#pragma unroll
        for (int r = 0; r < 16; ++r) { const float a = lda_<AT>(Ar[r] + k); acc0[r] = fmaf(a, b0, acc0[r]); acc1[r] = fmaf(a, b1, acc1[r]); }
    }
#pragma unroll
    for (int r = 0; r < 16; ++r) if (r0 + r < Mv) epi.store(z, r0 + r, p, acc0[r], acc1[r]);
}
struct EpiRot {
    const int* pos; bf16* out; int seg; float scale;
    __device__ void cols(int p, int& n0, int& n1) const { n0 = seg * 1024 + (p >> 6) * 128 + (p & 63); n1 = n0 + 64; }
    __device__ void store(int, int r, int p, float a0, float a1) const {
        float c, s; rot_cs(pos[r], p & 63, c, s);
        const int col = (p >> 6) * 128 + (p & 63);
        out[(size_t)r * DM + col] = (bf16)f2bf((a0 * c - a1 * s) * scale); out[(size_t)r * DM + col + 64] = (bf16)f2bf((a1 * c + a0 * s) * scale);
    }
};
struct EpiAct {
    bf16* out; int seg; int act;
    __device__ void cols(int p, int& n0, int& n1) const { n0 = seg * 1024 + p; n1 = -1; }
    __device__ void store(int, int r, int p, float a0, float) const {
        float v = a0; if (act == 1) v = a0 * sigmoidf_(a0); else if (act == 2) v = sigmoidf_(a0);
        out[(size_t)r * DM + p] = (bf16)f2bf(v);
    }
};
struct EpiGateA {
    const bf16* ga; float* out;
    __device__ void cols(int p, int& n0, int& n1) const { n0 = p; n1 = -1; }
    __device__ void store(int, int r, int p, float a0, float) const { out[(size_t)r * DM + p] = bf2f(ga[(size_t)r * DM + p]) * a0; }
};
struct EpiGateB {
    const bf16* gb; const float* t; bf16* out;
    __device__ void cols(int p, int& n0, int& n1) const { n0 = p; n1 = -1; }
    __device__ void store(int, int r, int p, float a0, float) const { out[(size_t)r * DM + p] = (bf16)f2bf(t[(size_t)r * DM + p] + bf2f(gb[(size_t)r * DM + p]) * a0); }
};
struct EpiResid {
    const float* base; float* out;
    __device__ void cols(int p, int& n0, int& n1) const { n0 = p; n1 = -1; }
    __device__ void store(int, int r, int p, float a0, float) const { out[(size_t)r * DM + p] = base[(size_t)r * DM + p] + a0; }
};
struct EpiBf16 {
    bf16* out; int ld; int pad;
    __device__ void cols(int p, int& n0, int& n1) const { n0 = p; n1 = -1; }
    __device__ void store(int, int r, int p, float a0, float) const { out[(size_t)r * ld + p] = (bf16)f2bf(a0); }
};
__device__ __forceinline__ float swiglu_(float g, float u) {
    g = fminf(g, SW_LIMIT); u = fminf(fmaxf(u, -SW_LIMIT), SW_LIMIT);
    return (u + 1.0f) * (g * sigmoidf_(g * SW_ALPHA));
}
struct EpiSwiglu {
    const float* bias; const unsigned* cnt; bf16* act;
    __device__ void cols(int p, int& n0, int& n1) const { n0 = p; n1 = 1024 + p; }
    __device__ void store(int z, int r, int p, float a0, float a1) const {
        unsigned st = 0; for (int e = 0; e < z; ++e) st += cnt[e];
        act[(size_t)(st + r) * DFF + p] = (bf16)f2bf(swiglu_(a0 + bias[(size_t)z * 2048 + p], a1 + bias[(size_t)z * 2048 + 1024 + p]));
    }
};
struct EpiDown {
    const float* bias; const int* rowlist; const float* roww; bf16* out4;
    __device__ void cols(int p, int& n0, int& n1) const { n0 = p; n1 = -1; }
    __device__ void store(int z, int r, int p, float a0, float) const {
        const int ent = rowlist[(size_t)z * NT + r]; const float w = roww[(size_t)z * NT + r];
        out4[(size_t)ent * DM + p] = (bf16)f2bf(w * (a0 + bias[(size_t)z * DM + p]));
    }
};
struct EpiPle {
    const float* x2; const bf16* pp; float* out;
    __device__ void cols(int p, int& n0, int& n1) const { n0 = p; n1 = -1; }
    __device__ void store(int, int r, int p, float a0, float) const { out[(size_t)r * DM + p] = x2[(size_t)r * DM + p] + sigmoidf_(a0) * bf2f(pp[(size_t)r * DM + p]); }
};
template <class Epi>
__global__ void __launch_bounds__(256) gemm_down(const bf16* act, const unsigned* cnt, const float* W, Epi epi) {
    const int z = blockIdx.z; const int Mv = (int)cnt[z];
    const int r0 = blockIdx.y * 16; if (r0 >= Mv) return;
    unsigned st = 0; for (int e = 0; e < z; ++e) st += cnt[e];
    const int p = blockIdx.x * 256 + threadIdx.x;
    const float* Wz = W + (size_t)z * DFF * DM;
    const bf16* Ar[16];
#pragma unroll
    for (int r = 0; r < 16; ++r) { int rr = r0 + r; if (rr >= Mv) rr = Mv - 1; Ar[r] = act + (size_t)(st + rr) * DFF; }
    float acc0[16];
#pragma unroll
    for (int r = 0; r < 16; ++r) acc0[r] = 0.f;
    for (int k = 0; k < DFF; ++k) {
        const float b0 = Wz[(size_t)k * DM + p];
#pragma unroll
        for (int r = 0; r < 16; ++r) acc0[r] = fmaf(bf2f(Ar[r][k]), b0, acc0[r]);
    }
#pragma unroll
    for (int r = 0; r < 16; ++r) if (r0 + r < Mv) epi.store(z, r0 + r, p, acc0[r], 0.f);
}

__global__ void __launch_bounds__(256) ret_kv(const bf16* K, const bf16* V, float* kvt) {
    const int n = blockIdx.x, bh = blockIdx.y, b = bh / NH, h = bh % NH; const float lg = log_gamma_h(h);
    const size_t row0 = (size_t)b * SEQ + (size_t)n * CH;
    __shared__ float sk[CH][DH + 1]; __shared__ float sv[CH][DH + 1];
    for (int i = threadIdx.x; i < CH * DH; i += 256) { const int j = i >> 7, c = i & 127; const float z = __expf(lg * (float)(CH - 1 - j));
        sk[j][c] = bf2f(K[(row0 + j) * DM + h * DH + c]); sv[j][c] = z * bf2f(V[(row0 + j) * DM + h * DH + c]); }
    __syncthreads();
    float* o = kvt + ((size_t)bh * NCH + n) * DH * DH;
    for (int i = threadIdx.x; i < DH * DH; i += 256) { const int e = i >> 7, d = i & 127; float a = 0.f;
        for (int j = 0; j < CH; ++j) a = fmaf(sk[j][d], sv[j][e], a);
        o[(size_t)e * DH + d] = a; }
}
__global__ void __launch_bounds__(256) ret_scan(const float* kvt, bf16* prevt) {
    const int idx = blockIdx.x * 256 + threadIdx.x; const int bh = idx / (DH * DH), ed = idx % (DH * DH); const int h = bh % NH;
    const float dec = __expf(log_gamma_h(h) * (float)CH); float st = 0.f;
    for (int n = 0; n < NCH; ++n) { const size_t o = ((size_t)bh * NCH + n) * DH * DH + ed; prevt[o] = (bf16)f2bf(st); st = st * dec + kvt[o]; }
}
__global__ void __launch_bounds__(128) ret_out(const bf16* Q, const bf16* K, const bf16* V, const bf16* prevt, const bf16* SG, const float* gn, bf16* YM) {
    const int t = blockIdx.x, h = blockIdx.y, b = t / SEQ, tt = t % SEQ, n = tt / CH, i = tt % CH, e = threadIdx.x; const float lg = log_gamma_h(h);
    __shared__ float sq[DH]; __shared__ float ss[CH]; __shared__ float red[4];
    sq[e] = bf2f(Q[(size_t)t * DM + h * DH + e]);
    __syncthreads();
    { const int j = e; float a = 0.f; if (j <= i) { const bf16* kr = K + ((size_t)b * SEQ + (size_t)n * CH + j) * DM + h * DH; for (int d = 0; d < DH; ++d) a = fmaf(sq[d], bf2f(kr[d]), a); a *= __expf(lg * (float)(i - j)); } ss[j] = a; }
    __syncthreads();
    float inner = 0.f; for (int j = 0; j <= i; ++j) inner = fmaf(ss[j], bf2f(V[((size_t)b * SEQ + (size_t)n * CH + j) * DM + h * DH + e]), inner);
    const bf16* pt = prevt + (((size_t)(b * NH + h)) * NCH + n) * DH * DH + (size_t)e * DH; float cr = 0.f;
    for (int d = 0; d < DH; ++d) cr = fmaf(sq[d], bf2f(pt[d]), cr);
    const float r = inner + __expf(lg * (float)(i + 1)) * cr;
    float s1 = wave_sum(r); if ((e & 63) == 0) red[e >> 6] = s1; __syncthreads(); const float mu = (red[0] + red[1]) * (1.0f / DH);
    const float dv = r - mu; float s2 = wave_sum(dv * dv); if ((e & 63) == 0) red[2 + (e >> 6)] = s2; __syncthreads(); const float var = (red[2] + red[3]) * (1.0f / DH);
    const float y = dv * rsqrtf(var + GN_EPS) * gn[h * DH + e];
    const float yb = bf2f(f2bf(y));
    (void)yb;
    YM[(size_t)t * 2048 + h * DH + e] = (bf16)f2bf(bf2f(SG[(size_t)t * DM + h * DH + e]) * y);
}
__global__ void __launch_bounds__(256) pool_mixed(const bf16* U, bf16* YM) {
    const size_t idx = (size_t)blockIdx.x * 256 + threadIdx.x; const int t = (int)(idx >> 10), c = (int)(idx & 1023); const int tt = t % SEQ; const int w = 2 << (c >> 8);
    const int cnt = tt + 1 < w ? tt + 1 : w; float s = 0.f;
    for (int k = 0; k < cnt; ++k) s += bf2f(U[(size_t)(t - k) * DM + c]);
    YM[(size_t)t * 2048 + 1024 + c] = (bf16)f2bf(s / (float)cnt - bf2f(U[(size_t)t * DM + c]));
}
__global__ void __launch_bounds__(256) pool_proj(const bf16* YM, const float* wp, const float* scale, float* out) {
    const int g = blockIdx.x, r0 = blockIdx.y * 16, dd = threadIdx.x; float acc[16];
#pragma unroll
    for (int r = 0; r < 16; ++r) acc[r] = 0.f;
    for (int c = 0; c < 256; ++c) { const float w = wp[((size_t)g * 256 + c) * 256 + dd];
#pragma unroll
        for (int r = 0; r < 16; ++r) acc[r] = fmaf(bf2f(YM[(size_t)(r0 + r) * 2048 + 1024 + g * 256 + c]), w, acc[r]); }
#pragma unroll
    for (int r = 0; r < 16; ++r) out[(size_t)(r0 + r) * DM + g * 256 + dd] = acc[r] * scale[g * 256 + dd];
}
__global__ void __launch_bounds__(256) router(const float* x1, const float* g, const float* wr, const float* br, bf16* h2, int* tope, float* topw) {
    const int t = blockIdx.x * 4 + (threadIdx.x >> 6), lane = threadIdx.x & 63;
    const float* xr = x1 + (size_t)t * DM; float v[16]; float s = 0.f;
#pragma unroll
    for (int j = 0; j < 16; ++j) { v[j] = xr[lane + 64 * j]; s += v[j] * v[j]; }
    const float rs = rsqrtf(wave_sum(s) * (1.0f / DM) + RMS_EPS);
#pragma unroll
    for (int j = 0; j < 16; ++j) { v[j] = v[j] * rs * g[lane + 64 * j]; h2[(size_t)t * DM + lane + 64 * j] = (bf16)f2bf(v[j]); }
    const int e = lane & 31; float lg = 0.f;
#pragma unroll
    for (int j = 0; j < 16; ++j)
        for (int l = 0; l < 64; ++l) { const float hv = __shfl(v[j], l); lg = fmaf(hv, wr[(size_t)(l + 64 * j) * NE + e], lg); }
    lg += br[e];
    float val = lg; int sel[4]; float sv[4];
#pragma unroll
    for (int k = 0; k < 4; ++k) {
        float m = val; int mi = e;
#pragma unroll
        for (int o = 1; o < 32; o <<= 1) { const float om = __shfl_xor(m, o); const int oi = __shfl_xor(mi, o); if (om > m || (om == m && oi < mi)) { m = om; mi = oi; } }
        sel[k] = mi; sv[k] = m; if (e == mi) val = -INFINITY;
    }
    const float e0 = 1.f, e1 = __expf(sv[1] - sv[0]), e2 = __expf(sv[2] - sv[0]), e3 = __expf(sv[3] - sv[0]); const float inv = 1.f / (e0 + e1 + e2 + e3);
    if (lane == 0) { tope[t * 4 + 0] = sel[0]; tope[t * 4 + 1] = sel[1]; tope[t * 4 + 2] = sel[2]; tope[t * 4 + 3] = sel[3];
        topw[t * 4 + 0] = e0 * inv; topw[t * 4 + 1] = e1 * inv; topw[t * 4 + 2] = e2 * inv; topw[t * 4 + 3] = e3 * inv; }
}
__global__ void __launch_bounds__(64) build_lists(const int* tope, const float* topw, int* rowlist, float* roww, unsigned* cnt) {
    const int e = blockIdx.x, lane = threadIdx.x; unsigned base = 0;
    for (int a0 = 0; a0 < NT * TOPK; a0 += 64) { const int a = a0 + lane; const bool hit = tope[a] == e;
        const unsigned long long m = __ballot(hit); const unsigned before = __popcll(m & ((1ull << lane) - 1ull));
        if (hit) { rowlist[(size_t)e * NT + base + before] = a; roww[(size_t)e * NT + base + before] = topw[a]; }
        base += __popcll(m); }
    if (lane == 0) cnt[e] = base;
}
__global__ void __launch_bounds__(256) combine(const float* x1, const bf16* out4, const float* g, float* x2, bf16* h3) {
    const int t = blockIdx.x * 4 + (threadIdx.x >> 6), lane = threadIdx.x & 63; float v[16]; float s = 0.f;
#pragma unroll
    for (int j = 0; j < 16; ++j) { const int c = lane + 64 * j; float a = x1[(size_t)t * DM + c];
        for (int k = 0; k < 4; ++k) a += bf2f(out4[((size_t)t * 4 + k) * DM + c]);
        v[j] = a; s += a * a; x2[(size_t)t * DM + c] = a; }
    const float rs = rsqrtf(wave_sum(s) * (1.0f / DM) + RMS_EPS);
#pragma unroll
    for (int j = 0; j < 16; ++j) h3[(size_t)t * DM + lane + 64 * j] = (bf16)f2bf(v[j] * rs * g[lane + 64 * j]);
}
__global__ void __launch_bounds__(256) final_norm(float* out, const float* g) {
    const int row = blockIdx.x * 4 + (threadIdx.x >> 6), lane = threadIdx.x & 63; float* xr = out + (size_t)row * DM; float v[16]; float s = 0.f;
#pragma unroll
    for (int j = 0; j < 16; ++j) { v[j] = xr[lane + 64 * j]; s += v[j] * v[j]; }
    const float rs = rsqrtf(wave_sum(s) * (1.0f / DM) + RMS_EPS);
#pragma unroll
    for (int j = 0; j < 16; ++j) xr[lane + 64 * j] = v[j] * rs * g[lane + 64 * j];
}
}

template <class Epi, typename AT>
static void launch_gemm(hipStream_t st, dim3 grid, const AT* A, int lda, const int* rowmap, int rowshift, const unsigned* cntp, int M, const float* W, int ldw, size_t wstride, int K, const Epi& epi) {
    nv::GArgs<Epi> a; memset(&a, 0, sizeof(a));
    a.A = A; a.rowmap = rowmap; a.cntp = cntp; a.W = W; a.wstride = wstride; a.lda = lda; a.rowshift = rowshift; a.M = M; a.ldw = ldw; a.K = K; a.epi = epi;
    nv::gemm<Epi, AT><<<grid, 256, 0, st>>>(a);
}
enum { S_H = 1, S_G1 = 2, S_RKV = 4, S_SCAN = 8, S_ROUT = 16, S_POOL = 32, S_MERGE = 64, S_X1 = 128, S_ROUTER = 256, S_GU = 512, S_DOWN = 1024, S_COMB = 2048, S_PP = 4096, S_PLE = 8192, S_FIN = 16384 };
static void naive_forward(void* const* d_in, float* out, unsigned char* ws, hipStream_t st, unsigned run) {
    const float* x = (const float*)d_in[0]; const float* p = (const float*)d_in[1]; const int* pos = (const int*)d_in[2];
    const float* g_mix = (const float*)d_in[3]; const float* w_in = (const float*)d_in[4]; const float* g_ret = (const float*)d_in[5];
    const float* w_pool = (const float*)d_in[6]; const float* pool_scale = (const float*)d_in[7]; const float* w_branch = (const float*)d_in[8];
    const float* w_out = (const float*)d_in[9]; const float* g_ffn = (const float*)d_in[10]; const float* w_router = (const float*)d_in[11];
    const float* b_router = (const float*)d_in[12]; const float* w_gu = (const float*)d_in[13]; const float* b_gu = (const float*)d_in[14];
    const float* w_down = (const float*)d_in[15]; const float* b_down = (const float*)d_in[16]; const float* g_ple = (const float*)d_in[17];
    const float* w_pg = (const float*)d_in[18]; const float* w_pp = (const float*)d_in[19]; const float* g_final = (const float*)d_in[20];
    bf16* H = (bf16*)(ws + WS_H); bf16* Q = (bf16*)(ws + WS_Q); bf16* K = (bf16*)(ws + WS_K); bf16* V = (bf16*)(ws + WS_V);
    bf16* SG = (bf16*)(ws + WS_SG); bf16* U = (bf16*)(ws + WS_U); bf16* GA = (bf16*)(ws + WS_GA); bf16* GB = (bf16*)(ws + WS_GB);
    float* KVT = (float*)(ws + WS_KVT); bf16* PREVT = (bf16*)(ws + WS_PREVT); bf16* YM = (bf16*)(ws + WS_YM); bf16* MERGED = (bf16*)(ws + WS_MERGED);
    float* X1 = (float*)(ws + WS_X1); bf16* H2 = (bf16*)(ws + WS_H2); float* X2 = (float*)(ws + WS_X2); bf16* H3 = (bf16*)(ws + WS_H3);
    bf16* ACT = (bf16*)(ws + WS_ACT); bf16* OUT4 = (bf16*)(ws + WS_OUT4); bf16* PP = (bf16*)(ws + WS_PP);
    float* TMPA = (float*)(ws + WS_TMPA); float* TMPB = (float*)(ws + WS_TMPB);
    int* TOPE = (int*)(ws + WS_TOPE); float* TOPW = (float*)(ws + WS_TOPW); int* ROWLIST = (int*)(ws + WS_ROWLIST); float* ROWW = (float*)(ws + WS_ROWW);
    unsigned* CNT = (unsigned*)(ws + WS_CTL) + CW_CNT;
    if (run & S_H) nv::rmsnorm_rows<<<NT / 4, 256, 0, st>>>(x, g_mix, H, nullptr, NT);
    if (run & S_G1) launch_gemm<nv::EpiRot, bf16>(st, dim3(2, NT / 16, 1), H, DM, nullptr, 0, nullptr, NT, w_in, INW, 0, DM, nv::EpiRot{pos, Q, 0, 1.0f});
    if (run & S_G1) launch_gemm<nv::EpiRot, bf16>(st, dim3(2, NT / 16, 1), H, DM, nullptr, 0, nullptr, NT, w_in, INW, 0, DM, nv::EpiRot{pos, K, 1, 0.08838834764831845f});
    if (run & S_G1) launch_gemm<nv::EpiAct, bf16>(st, dim3(4, NT / 16, 1), H, DM, nullptr, 0, nullptr, NT, w_in, INW, 0, DM, nv::EpiAct{V, 2, 0});
    if (run & S_G1) launch_gemm<nv::EpiAct, bf16>(st, dim3(4, NT / 16, 1), H, DM, nullptr, 0, nullptr, NT, w_in, INW, 0, DM, nv::EpiAct{SG, 3, 1});
    if (run & S_G1) launch_gemm<nv::EpiAct, bf16>(st, dim3(4, NT / 16, 1), H, DM, nullptr, 0, nullptr, NT, w_in, INW, 0, DM, nv::EpiAct{U, 4, 0});
    if (run & S_G1) launch_gemm<nv::EpiAct, bf16>(st, dim3(4, NT / 16, 1), H, DM, nullptr, 0, nullptr, NT, w_in, INW, 0, DM, nv::EpiAct{GA, 5, 2});
    if (run & S_G1) launch_gemm<nv::EpiAct, bf16>(st, dim3(4, NT / 16, 1), H, DM, nullptr, 0, nullptr, NT, w_in, INW, 0, DM, nv::EpiAct{GB, 6, 2});
    if (run & S_RKV) nv::ret_kv<<<dim3(NCH, NB * NH), 256, 0, st>>>(K, V, KVT);
    if (run & S_SCAN) nv::ret_scan<<<NB * NH * DH * DH / 256, 256, 0, st>>>(KVT, PREVT);
    if (run & S_ROUT) nv::ret_out<<<dim3(NT, NH), 128, 0, st>>>(Q, K, V, PREVT, SG, g_ret, YM);
    if (run & S_POOL) nv::pool_mixed<<<NT * DM / 256, 256, 0, st>>>(U, YM);
    if (run & S_MERGE) nv::pool_proj<<<dim3(4, NT / 16), 256, 0, st>>>(YM, w_pool, pool_scale, TMPA);
    if (run & S_MERGE) launch_gemm<nv::EpiGateA, bf16>(st, dim3(4, NT / 16, 1), YM, 2048, nullptr, 0, nullptr, NT, w_branch, DM, 0, DM, nv::EpiGateA{GA, TMPB});
    if (run & S_MERGE) launch_gemm<nv::EpiGateB, float>(st, dim3(4, NT / 16, 1), TMPA, DM, nullptr, 0, nullptr, NT, w_branch + (size_t)DM * DM, DM, 0, DM, nv::EpiGateB{GB, TMPB, MERGED});
    if (run & S_X1) launch_gemm<nv::EpiResid, bf16>(st, dim3(4, NT / 16, 1), MERGED, DM, nullptr, 0, nullptr, NT, w_out, DM, 0, DM, nv::EpiResid{x, X1});
    if (run & S_ROUTER) nv::router<<<NT / 4, 256, 0, st>>>(X1, g_ffn, w_router, b_router, H2, TOPE, TOPW);
    if (run & S_ROUTER) nv::build_lists<<<NE, 64, 0, st>>>(TOPE, TOPW, ROWLIST, ROWW, CNT);
    if (run & S_GU) launch_gemm<nv::EpiSwiglu, bf16>(st, dim3(4, NT / 16, NE), H2, DM, ROWLIST, 2, CNT, NT, w_gu, 2048, (size_t)DM * 2048, DM, nv::EpiSwiglu{b_gu, CNT, ACT});
    if (run & S_DOWN) nv::gemm_down<nv::EpiDown><<<dim3(4, NT / 16, NE), 256, 0, st>>>(ACT, CNT, w_down, nv::EpiDown{b_down, ROWLIST, ROWW, OUT4});
    if (run & S_COMB) nv::combine<<<NT / 4, 256, 0, st>>>(X1, OUT4, g_ple, X2, H3);
    if (run & S_PP) launch_gemm<nv::EpiBf16, float>(st, dim3(4, NT / 16, 1), p, PLE, nullptr, 0, nullptr, NT, w_pp, DM, 0, PLE, nv::EpiBf16{PP, DM, 0});
    if (run & S_PLE) launch_gemm<nv::EpiPle, bf16>(st, dim3(4, NT / 16, 1), H3, DM, nullptr, 0, nullptr, NT, w_pg, DM, 0, DM, nv::EpiPle{X2, PP, out});
    if (run & S_FIN) nv::final_norm<<<NT / 4, 256, 0, st>>>(out, g_final);
}
#endif


#define LAS __attribute__((address_space(3)))
#define GAS __attribute__((address_space(1)))
typedef short bf16x8 __attribute__((ext_vector_type(8)));
typedef float f32x16 __attribute__((ext_vector_type(16)));
typedef GAS unsigned gu32;
#define RLX_AGENT __ATOMIC_RELAXED, __HIP_MEMORY_SCOPE_AGENT
#define LDS_WAIT() asm volatile("s_waitcnt lgkmcnt(0)" ::: "memory")
#define VM_WAIT() asm volatile("s_waitcnt vmcnt(0)" ::: "memory")
__device__ __forceinline__ unsigned pk2(float lo, float hi) { return f2bf(lo) | (f2bf(hi) << 16); }
typedef float f32x2_t __attribute__((ext_vector_type(2))); typedef __bf16 bf16x2_t __attribute__((ext_vector_type(2)));
__device__ __forceinline__ unsigned cvt_pk_bf16(float lo, float hi) { f32x2_t v = {lo, hi}; bf16x2_t b = __builtin_convertvector(v, bf16x2_t); return __builtin_bit_cast(unsigned, b); }
__device__ __forceinline__ float fast_sigmoid(float x) { return __builtin_amdgcn_rcpf(1.0f + __builtin_amdgcn_exp2f(-1.4426950408889634f * x)); }

__device__ __forceinline__ int lane_id() { unsigned m = ~0u; asm volatile("" : "+s"(m)); return (int)__builtin_amdgcn_mbcnt_hi(m, __builtin_amdgcn_mbcnt_lo(m, 0u)); }
constexpr int NWAVES = 8;
constexpr int RING_OFF = 0, RING_BYTES = 131072;
constexpr int LDSCTL_OFF = RING_BYTES, MISC_OFF = LDSCTL_OFF + 320;
constexpr int LDS_TAB_OFF = LDSCTL_OFF + 1024;
constexpr int LDS_BYTES = 163840;
static_assert(LDS_TAB_OFF + 6480 * 4 <= LDS_BYTES, "LDS table region");
constexpr int CW_BAR = 4096;

#define XB_TMO      128
#define XB_XCNT(j)  (256  + 64 * (j))
#define XB_XSUB(j)  (1280 + 64 * (j))
#define XB_XGEN(j)  (2304 + 64 * (j))
#define XB_TOP      3328
#define XB_TOPGEN   3392
#define XCD_BAR_WORDS 3456
#define XB_SPIN_CAP (1u << 18)
__device__ __forceinline__ unsigned xb_ld(unsigned* p)              { return __hip_atomic_load(p, __ATOMIC_RELAXED, __HIP_MEMORY_SCOPE_AGENT); }
__device__ __forceinline__ unsigned xb_add(unsigned* p, unsigned v) { return __hip_atomic_fetch_add(p, v, __ATOMIC_RELAXED, __HIP_MEMORY_SCOPE_AGENT); }
__device__ __forceinline__ unsigned xb_xcc_id() { return (unsigned)__builtin_amdgcn_s_getreg((3 << 11) | 20) & 0xFu; }
#define XB_SPIN(cond, bar) do { unsigned _sp = 0; while (cond) { __builtin_amdgcn_s_sleep(1); \
    if ((++_sp & 255u) == 0u) { if (xb_ld(&(bar)[XB_TMO])) break; if (_sp > XB_SPIN_CAP) { atomicAdd(&(bar)[XB_TMO], 1u); break; } } } } while (0)
struct XcdBarrier { unsigned* bar; unsigned x; volatile LAS unsigned* st; int wave; };
__device__ __forceinline__ XcdBarrier xcd_barrier_post(unsigned* bar, volatile LAS unsigned* st, int wave) {
    XcdBarrier b; b.bar = bar; b.x = xb_xcc_id(); b.st = st; b.wave = wave;
    if (wave == 0 && lane_id() == 0) (void)xb_add(&bar[XB_XCNT(b.x)], 1u);
    return b;
}
__device__ __forceinline__ void xcd_barrier_complete(unsigned* bar, unsigned x, unsigned& nloc, unsigned& nx) {
    const unsigned G = gridDim.x * gridDim.y * gridDim.z;
    unsigned sum, cnt, mine, sp = 0u;
    for (;;) {
        sum = 0u; cnt = 0u; mine = 0u;
#pragma unroll
        for (unsigned j = 0; j < 16; ++j) { const unsigned c = xb_ld(&bar[XB_XCNT(j)]); sum += c; cnt += (c > 0u) ? 1u : 0u; mine = (j == x) ? c : mine; }
        if (sum == G) break;
        __builtin_amdgcn_s_sleep(1);
        if ((++sp & 255u) == 0u) { if (xb_ld(&bar[XB_TMO])) break; if (sp > XB_SPIN_CAP) { atomicAdd(&bar[XB_TMO], 1u); break; } }
    }
    nloc = mine > 0u ? mine : 1u; nx = cnt > 0u ? cnt : 1u;
}
__device__ __forceinline__ void xcd_barrier(const XcdBarrier& b) {
    asm volatile("s_waitcnt vmcnt(0)" ::: "memory");
    __syncthreads();
    if (b.wave == 0 && lane_id() == 0) {
        unsigned* bar = b.bar;
        __builtin_amdgcn_s_waitcnt(0);
        unsigned nloc = b.st[0], nx = b.st[1];
        if (nloc == 0u) { xcd_barrier_complete(bar, b.x, nloc, nx); b.st[0] = nloc; b.st[1] = nx; }
        const unsigned old = xb_add(&bar[XB_XSUB(b.x)], 1u);
        const unsigned gen = old / nloc;
        if (old + 1u == (gen + 1u) * nloc) {
            __builtin_amdgcn_fence(__ATOMIC_RELEASE, "agent");
            asm volatile("s_waitcnt vmcnt(0)" ::: "memory");
            const unsigned og = xb_add(&bar[XB_TOP], 1u);
            const unsigned tg = og / nx;
            if (og + 1u == (tg + 1u) * nx) xb_add(&bar[XB_TOPGEN], 1u);
            else XB_SPIN(xb_ld(&bar[XB_TOPGEN]) == tg, bar);
            __builtin_amdgcn_fence(__ATOMIC_ACQUIRE, "agent");
            xb_add(&bar[XB_XGEN(b.x)], 1u);
            asm volatile("s_waitcnt vmcnt(0)" ::: "memory");
        } else {
            XB_SPIN(xb_ld(&bar[XB_XGEN(b.x)]) == gen, bar);
            __builtin_amdgcn_fence(__ATOMIC_ACQUIRE, "agent");
            asm volatile("s_waitcnt vmcnt(0)" ::: "memory");
        }
    }
    __syncthreads();
}

namespace pg8 {
constexpr int BM = 256, BK = 64, HALF = 128, HTB = HALF * BK * 2, STAGE_BYTES = 8 * HTB, NXCD = 8, WGM = 8;
__host__ __device__ __forceinline__ int lds_byte(int r, int c) { const int st = (r >> 4) * 2 + (c >> 5), rr = r & 15, cc = c & 31, ob = rr * 64 + cc * 2; return st * 1024 + (ob ^ (((ob >> 9) & 1) << 5)); }
__host__ __device__ __forceinline__ void stage_rc(int b, int& R, int& C) { const int st = b / 1024, sb = b % 1024, swz = sb ^ (((sb >> 9) & 1) << 5); R = (st >> 1) * 16 + swz / 64; C = (st & 1) * 32 + (swz % 64) / 2; }
__host__ __device__ __forceinline__ int perm32(int rho) { const int n = rho >> 4, i = rho & 15; return 8 * (i >> 2) + 4 * n + (i & 3); }

typedef int i32x8 __attribute__((ext_vector_type(8))); typedef int i32x4 __attribute__((ext_vector_type(4)));
struct Unit { int pm, pn, e, nvalid; unsigned aoff, boff; int slot, keep; };
typedef f32x4 Acc[2][2][4][2];

struct StaticOrder {
    int nM, nN, nwg, G, c, K;
    __device__ void init(int M, int N, int K_, int G_, int c_) { nM = M / BM; nN = N / BM; nwg = nM * nN; G = G_; c = c_; K = K_; }
    __device__ bool next(int i, Unit& u) const {
        const long L = (long)i * G + c; if (L >= nwg) return false;
        int wgid = (int)L; { const int q = nwg / NXCD, r = nwg % NXCD, xcd = wgid % NXCD, off = wgid / NXCD; wgid = (xcd < r ? xcd * (q + 1) : r * (q + 1) + (xcd - r) * q) + off; }
        const int nig = WGM * nN, gid = wgid / nig, fm = gid * WGM, gsz = (nM - fm) < WGM ? (nM - fm) : WGM;
        u.pm = fm + ((wgid % nig) % gsz); u.pn = (wgid % nig) / gsz; u.e = 0; u.nvalid = BM; u.slot = 0; u.keep = 0;
        u.aoff = (unsigned)u.pm * (unsigned)(BM * K * 2); u.boff = (unsigned)u.pn * (unsigned)(BM * K * 2); return true;
    }
    __device__ __forceinline__ void gather(const Unit&, unsigned (&)[2][2]) const {}
};

struct TwoPartOrder {
    StaticOrder base;
    __device__ bool next(int i, Unit& u) const {
        if (!base.next(i >> 1, u)) return false;
        const int part = i & 1; u.aoff = (unsigned)u.pm * (unsigned)(BM * 2048 * 2) + (unsigned)part * 2048u; u.boff = (unsigned)u.pn * (unsigned)(BM * 2048 * 2) + (unsigned)part * 2048u; u.keep = part == 0; return true;
    }
    __device__ __forceinline__ void gather(const Unit&, unsigned (&)[2][2]) const {}
};
template <class Epi, class Sched, bool ALIGN_EPI, bool GATHER, bool F8 = false>
__device__ __forceinline__ void gemm_phase(LAS unsigned char* lds, const int K, const int lda, const int ldb, const char* Ab, const char* Bb, const Sched& S, const Epi& E, const int wid) {
    const int lane = lane_id(), tid = wid * 64 + lane, wr = wid >> 2, wc = wid & 3, fr = lane & 15, fq = lane >> 4;
    constexpr int EB = F8 ? 1 : 2;
    int nt = K * EB / 128; asm volatile("" : "+s"(nt));
    unsigned voffA[2][2], voffB[2];
    const unsigned hstep = (unsigned)(HALF * ldb * EB);
#pragma unroll
    for (int i = 0; i < 2; ++i) { int R, C; stage_rc(tid * 16 + i * 8192, R, C); const int Rb = Epi::PERM ? ((R & ~31) + perm32(R & 31)) : R;
        voffA[0][i] = (unsigned)(R * lda * EB + C * 2); voffA[1][i] = voffA[0][i] + (unsigned)(HALF * lda * EB); voffB[i] = (unsigned)(Rb * ldb * EB + C * 2); }
    const size_t kstep = (size_t)(BK * 2);
    const unsigned ldsw = (unsigned)wid * 1024u; const unsigned ldsb = (unsigned)__builtin_amdgcn_readfirstlane((int)(unsigned)(size_t)lds);
    const int aoff = F8 ? lds_byte(wr * 64 + fr, fq * 16) : lds_byte(wr * 64 + fr, fq * 8), boff = F8 ? lds_byte(wc * 32 + fr, fq * 16) : lds_byte(wc * 32 + fr, fq * 8);
#define PG8_SA(b, h) (((b) * 2 + (h)) * HTB)
#define PG8_SB(b, h) ((4 + (b) * 2 + (h)) * HTB)
#define PG8_STAGE(bufoff, gbase, voff) do { _Pragma("unroll") for (int _i = 0; _i < 2; ++_i) { unsigned keep_; \
        asm volatile("s_nop 4\n\ts_mov_b32 %0, m0\n\ts_mov_b32 m0, %3\n\ts_nop 0\n\tglobal_load_lds_dwordx4 %1, %2\n\ts_mov_b32 m0, %0" \
            : "=&s"(keep_) : "v"((voff)[_i]), "s"((const char*)(gbase)), "s"(ldsb + (unsigned)(bufoff) + ldsw + (unsigned)(_i * 8192)) : "memory"); } } while (0)
#define PG8_LDA(dst, b, h) do { if constexpr (F8) { _Pragma("unroll") for (int m = 0; m < 4; ++m) { const LAS i32x4* p_ = (const LAS i32x4*)(lds + PG8_SA(b, h) + aoff + m * 2048); const i32x4 lo_ = p_[0], hi_ = p_[1]; dst##8[m] = __builtin_shufflevector(lo_, hi_, 0, 1, 2, 3, 4, 5, 6, 7); } } \
        else { _Pragma("unroll") for (int m = 0; m < 4; ++m) _Pragma("unroll") for (int k = 0; k < 2; ++k) dst[m][k] = *(const LAS bf16x8*)(lds + PG8_SA(b, h) + aoff + m * 2048 + k * 1024); } } while (0)
#define PG8_LDB(dst, b, h) do { if constexpr (F8) { _Pragma("unroll") for (int n = 0; n < 2; ++n) { const LAS i32x4* p_ = (const LAS i32x4*)(lds + PG8_SB(b, h) + boff + n * 2048); const i32x4 lo_ = p_[0], hi_ = p_[1]; dst##8[n] = __builtin_shufflevector(lo_, hi_, 0, 1, 2, 3, 4, 5, 6, 7); } } \
        else { _Pragma("unroll") for (int n = 0; n < 2; ++n) _Pragma("unroll") for (int k = 0; k < 2; ++k) dst[n][k] = *(const LAS bf16x8*)(lds + PG8_SB(b, h) + boff + n * 2048 + k * 1024); } } while (0)
#define PG8_MMA(ai, bj, At, Bt) do { __builtin_amdgcn_s_setprio(1); _Pragma("unroll") for (int m = 0; m < 4; ++m) _Pragma("unroll") for (int n = 0; n < 2; ++n) { \
        if constexpr (F8) { acc[ai][bj][m][n] = __builtin_amdgcn_mfma_scale_f32_16x16x128_f8f6f4(Bt##8[n], At##8[m], acc[ai][bj][m][n], 0, 0, 0, 0, 0, 0); } \
        else { _Pragma("unroll") for (int k = 0; k < 2; ++k) acc[ai][bj][m][n] = __builtin_amdgcn_mfma_f32_16x16x32_bf16(Bt[n][k], At[m][k], acc[ai][bj][m][n], 0, 0, 0); } } __builtin_amdgcn_s_setprio(0); } while (0)
#define PG8_WAIT_V(n) asm volatile("s_waitcnt vmcnt(" #n ")" ::: "memory")
#define PG8_WAIT_L(n) asm volatile("s_waitcnt lgkmcnt(" #n ")" ::: "memory")
#define PG8_BAR __builtin_amdgcn_s_barrier()
#define PG8_SCHED __builtin_amdgcn_sched_barrier(0)
    Unit cur, nxt; int ui = 0;
    if (!S.next(0, cur)) return;
    Acc acc;
#pragma unroll
    for (int a = 0; a < 2; ++a)
#pragma unroll
        for (int b = 0; b < 2; ++b)
#pragma unroll
            for (int m = 0; m < 4; ++m)
#pragma unroll
                for (int n = 0; n < 2; ++n) acc[a][b][m][n] = (f32x4){0.f, 0.f, 0.f, 0.f};
    bf16x8 At[4][2], B0[2][2], B1[2][2]; i32x8 At8[4], B08[2], B18[2];
    const char* cA = Ab + cur.aoff; const char* cB = Bb + cur.boff;
    if constexpr (GATHER) S.gather(cur, voffA);
    PG8_STAGE(PG8_SB(0, 0), cB, voffB); PG8_STAGE(PG8_SB(0, 1), cB + hstep, voffB); PG8_STAGE(PG8_SA(0, 0), cA, voffA[0]); PG8_STAGE(PG8_SA(0, 1), cA, voffA[1]);
    if (wr == 1) PG8_BAR;
    PG8_WAIT_V(2); PG8_BAR;
    PG8_STAGE(PG8_SB(1, 0), cB + kstep, voffB); PG8_STAGE(PG8_SA(1, 0), cA + kstep, voffA[0]); PG8_STAGE(PG8_SB(1, 1), cB + hstep + kstep, voffB);
    PG8_WAIT_V(6); PG8_BAR;
    for (;;) {
        const bool has_next = S.next(ui + 1, nxt);
        const char* nA = has_next ? Ab + nxt.aoff : cA; const char* nB = has_next ? Bb + nxt.boff : cB;
#pragma nounroll
        for (int t = 0; t < nt; t += 2) {
            const bool last = (t == nt - 2);
            const char* a1 = cA + (size_t)(t + 1) * kstep;
            const char* a2 = last ? nA : cA + (size_t)(t + 2) * kstep; const char* b2 = last ? nB : cB + (size_t)(t + 2) * kstep;
            const char* a3 = a2 + kstep; const char* b3 = b2 + kstep;
            PG8_LDB(B0, 0, 0); PG8_LDB(B1, 0, 1); PG8_SCHED; PG8_LDA(At, 0, 0); PG8_STAGE(PG8_SA(1, 1), a1, voffA[1]);
            if constexpr (GATHER) { if (last && has_next) S.gather(nxt, voffA); }
            PG8_WAIT_V(8); PG8_WAIT_L(0); PG8_BAR; PG8_MMA(0, 0, At, B0); PG8_MMA(0, 1, At, B1); PG8_BAR; PG8_SCHED;
            PG8_LDA(At, 0, 1); PG8_STAGE(PG8_SB(0, 0), b2, voffB); PG8_STAGE(PG8_SB(0, 1), b2 + hstep, voffB); PG8_STAGE(PG8_SA(0, 0), a2, voffA[0]);
            PG8_WAIT_V(8); PG8_WAIT_L(0); PG8_BAR; PG8_MMA(1, 0, At, B0); PG8_MMA(1, 1, At, B1); PG8_BAR; PG8_SCHED;
            PG8_LDB(B0, 1, 0); PG8_LDB(B1, 1, 1); PG8_SCHED; PG8_LDA(At, 1, 0); PG8_STAGE(PG8_SA(0, 1), a2, voffA[1]);
            PG8_WAIT_V(8); PG8_WAIT_L(0); PG8_BAR; PG8_MMA(0, 0, At, B0); PG8_MMA(0, 1, At, B1); PG8_BAR; PG8_SCHED;
            PG8_LDA(At, 1, 1); PG8_STAGE(PG8_SB(1, 0), b3, voffB); PG8_STAGE(PG8_SB(1, 1), b3 + hstep, voffB); PG8_STAGE(PG8_SA(1, 0), a3, voffA[0]);
            PG8_WAIT_V(8); PG8_WAIT_L(0); PG8_BAR; PG8_MMA(1, 0, At, B0); PG8_MMA(1, 1, At, B1); PG8_BAR; PG8_SCHED;
        }
        if constexpr (ALIGN_EPI) { if (wr == 0) PG8_BAR; }
        E(acc, cur, wr, wc, fr, fq);
        if (!has_next) break;
#pragma unroll
        for (int a = 0; a < 2; ++a)
#pragma unroll
            for (int b = 0; b < 2; ++b)
#pragma unroll
                for (int m = 0; m < 4; ++m)
#pragma unroll
                    for (int n = 0; n < 2; ++n) acc[a][b][m][n] = (f32x4){0.f, 0.f, 0.f, 0.f};
        cur = nxt; cA = nA; cB = nB; ++ui;
        if constexpr (ALIGN_EPI) { if (wr == 1) PG8_BAR; }
    }
    PG8_WAIT_V(0);
    if constexpr (!ALIGN_EPI) { if (wr == 0) PG8_BAR; }
    PG8_BAR;
#undef PG8_SA
#undef PG8_SB
#undef PG8_STAGE
#undef PG8_LDA
#undef PG8_LDB
#undef PG8_MMA
#undef PG8_WAIT_V
#undef PG8_WAIT_L
#undef PG8_BAR
#undef PG8_SCHED
}

struct EpiIn {
    static constexpr bool PERM = true;
    bf16* outs;
    const float* trig;
    __device__ __forceinline__ void operator()(Acc& acc, const Unit& u, int wr, int wc, int fr, int fq) const {
        const int seg = u.pn >> 2, pl = u.pn & 3; const int row0 = u.pm * BM + wr * 64 + fr;
        bf16* base = outs + (size_t)seg * NT * DM;
        if (seg < 2) {
            const float sc = seg == 1 ? 0.08838834764831845f : 1.0f;
            const int head = 2 * pl + (wc >> 1), d0 = 32 * (wc & 1) + 8 * fq;
#pragma unroll
            for (int ai = 0; ai < 2; ++ai)
#pragma unroll
                for (int m = 0; m < 4; ++m) { const int row = row0 + ai * HALF + m * 16;
                    const f32x4* tp = (const f32x4*)(trig + ((size_t)row * 64 + d0) * 2);
                    const f32x4 t0 = tp[0], t1 = tp[1], t2 = tp[2], t3 = tp[3];
                    const f32x4 x1a = acc[ai][0][m][0], x1b = acc[ai][0][m][1], x2a = acc[ai][1][m][0], x2b = acc[ai][1][m][1];
                    u32x4 o1, o2;
                    o1.x = cvt_pk_bf16((x1a[0] * t0[0] - x2a[0] * t0[1]) * sc, (x1a[1] * t0[2] - x2a[1] * t0[3]) * sc);
                    o1.y = cvt_pk_bf16((x1a[2] * t1[0] - x2a[2] * t1[1]) * sc, (x1a[3] * t1[2] - x2a[3] * t1[3]) * sc);
                    o1.z = cvt_pk_bf16((x1b[0] * t2[0] - x2b[0] * t2[1]) * sc, (x1b[1] * t2[2] - x2b[1] * t2[3]) * sc);
                    o1.w = cvt_pk_bf16((x1b[2] * t3[0] - x2b[2] * t3[1]) * sc, (x1b[3] * t3[2] - x2b[3] * t3[3]) * sc);
                    o2.x = cvt_pk_bf16((x2a[0] * t0[0] + x1a[0] * t0[1]) * sc, (x2a[1] * t0[2] + x1a[1] * t0[3]) * sc);
                    o2.y = cvt_pk_bf16((x2a[2] * t1[0] + x1a[2] * t1[1]) * sc, (x2a[3] * t1[2] + x1a[3] * t1[3]) * sc);
                    o2.z = cvt_pk_bf16((x2b[0] * t2[0] + x1b[0] * t2[1]) * sc, (x2b[1] * t2[2] + x1b[1] * t2[3]) * sc);
                    o2.w = cvt_pk_bf16((x2b[2] * t3[0] + x1b[2] * t3[1]) * sc, (x2b[3] * t3[2] + x1b[3] * t3[3]) * sc);
                    bf16* rp = base + (size_t)row * DM + head * DH + d0;
                    *(u32x4*)rp = o1; *(u32x4*)(rp + 64) = o2; }
        } else {
            const int act = (seg == 3) ? 1 : (seg >= 5 ? 2 : 0);
            const int col0 = pl * BM + wc * 32 + 8 * fq;
#pragma unroll
            for (int ai = 0; ai < 2; ++ai)
#pragma unroll
                for (int m = 0; m < 4; ++m) { bf16* rp = base + (size_t)(row0 + ai * HALF + m * 16) * DM + col0;
#pragma unroll
                    for (int bj = 0; bj < 2; ++bj) { f32x4 v0 = acc[ai][bj][m][0], v1 = acc[ai][bj][m][1];
                        if (act) {
#pragma unroll
                            for (int i = 0; i < 4; ++i) { const float s0 = fast_sigmoid(v0[i]), s1 = fast_sigmoid(v1[i]); v0[i] = act == 1 ? v0[i] * s0 : s0; v1[i] = act == 1 ? v1[i] * s1 : s1; } }
                        u32x4 w; w.x = cvt_pk_bf16(v0[0], v0[1]); w.y = cvt_pk_bf16(v0[2], v0[3]); w.z = cvt_pk_bf16(v1[0], v1[1]); w.w = cvt_pk_bf16(v1[2], v1[3]);
                        *(u32x4*)(rp + bj * HALF) = w; } }
        }
    }
};
struct EpiPlainBf16 {
    static constexpr bool PERM = true;
    bf16* O; int ldc; int pad;
    __device__ __forceinline__ void operator()(Acc& acc, const Unit& u, int wr, int wc, int fr, int fq) const {
        const int row0 = u.pm * BM + wr * 64 + fr, col0 = u.pn * BM + wc * 32 + 8 * fq;
#pragma unroll
        for (int ai = 0; ai < 2; ++ai)
#pragma unroll
            for (int m = 0; m < 4; ++m) { bf16* rp = O + (size_t)(row0 + ai * HALF + m * 16) * ldc + col0;
#pragma unroll
                for (int bj = 0; bj < 2; ++bj) { const f32x4 v0 = acc[ai][bj][m][0], v1 = acc[ai][bj][m][1];
                    u32x4 w; w.x = cvt_pk_bf16(v0[0], v0[1]); w.y = cvt_pk_bf16(v0[2], v0[3]); w.z = cvt_pk_bf16(v1[0], v1[1]); w.w = cvt_pk_bf16(v1[2], v1[3]);
                    *(u32x4*)(rp + bj * HALF) = w; } }
    }
};

__device__ __forceinline__ void unpack8(const u32x4 w, float (&f)[8]) {
    f[0] = __builtin_bit_cast(float, w.x << 16); f[1] = __builtin_bit_cast(float, w.x & 0xffff0000u); f[2] = __builtin_bit_cast(float, w.y << 16); f[3] = __builtin_bit_cast(float, w.y & 0xffff0000u);
    f[4] = __builtin_bit_cast(float, w.z << 16); f[5] = __builtin_bit_cast(float, w.z & 0xffff0000u); f[6] = __builtin_bit_cast(float, w.w << 16); f[7] = __builtin_bit_cast(float, w.w & 0xffff0000u);
}
struct EpiMerged {
    static constexpr bool PERM = true;
    const bf16* GA; const bf16* GB; bf16* O; bf16* T1;
    __device__ __forceinline__ void operator()(Acc& acc, const Unit& u, int wr, int wc, int fr, int fq) const {
        const int row0 = u.pm * BM + wr * 64 + fr, col0 = u.pn * BM + wc * 32 + 8 * fq;
        const bf16* G = u.keep ? GA : GB;
#pragma unroll
        for (int ai = 0; ai < 2; ++ai)
#pragma unroll
            for (int m = 0; m < 4; ++m) { const size_t off = (size_t)(row0 + ai * HALF + m * 16) * DM + col0;
#pragma unroll
                for (int bj = 0; bj < 2; ++bj) { float g[8]; unpack8(*(const u32x4*)(G + off + bj * HALF), g); f32x4 v0 = acc[ai][bj][m][0], v1 = acc[ai][bj][m][1];
#pragma unroll
                    for (int i = 0; i < 4; ++i) { v0[i] *= g[i]; v1[i] *= g[4 + i]; }
                    bf16* tp = T1 + off + bj * HALF;
                    if (u.keep) { u32x4 w; w.x = cvt_pk_bf16(v0[0], v0[1]); w.y = cvt_pk_bf16(v0[2], v0[3]); w.z = cvt_pk_bf16(v1[0], v1[1]); w.w = cvt_pk_bf16(v1[2], v1[3]); *(u32x4*)tp = w; }
                    else { float t[8]; unpack8(*(const u32x4*)tp, t);
#pragma unroll
                        for (int i = 0; i < 4; ++i) { v0[i] += t[i]; v1[i] += t[4 + i]; }
                        u32x4 w; w.x = cvt_pk_bf16(v0[0], v0[1]); w.y = cvt_pk_bf16(v0[2], v0[3]); w.z = cvt_pk_bf16(v1[0], v1[1]); w.w = cvt_pk_bf16(v1[2], v1[3]);
                        *(u32x4*)(O + off + bj * HALF) = w; } }
                asm volatile("" ::: "memory"); }
    }
};
struct EpiResidF32 {
    static constexpr bool PERM = false;
    const float* base; float* out;
    __device__ __forceinline__ void operator()(Acc& acc, const Unit& u, int wr, int wc, int fr, int fq) const {
        const int row0 = u.pm * BM + wr * 64 + fr, col0 = u.pn * BM + wc * 32 + 4 * fq;
#pragma unroll
        for (int ai = 0; ai < 2; ++ai)
#pragma unroll
            for (int m = 0; m < 4; ++m) { const size_t off = (size_t)(row0 + ai * HALF + m * 16) * DM + col0;
#pragma unroll
                for (int bj = 0; bj < 2; ++bj)
#pragma unroll
                    for (int n = 0; n < 2; ++n) *(f32x4*)(out + off + bj * HALF + n * 16) = *(const f32x4*)(base + off + bj * HALF + n * 16) + acc[ai][bj][m][n]; }
    }
};
struct EpiPleOut {
    static constexpr bool PERM = false;
    const float* x2; const bf16* pp; float* out;
    __device__ __forceinline__ void operator()(Acc& acc, const Unit& u, int wr, int wc, int fr, int fq) const {
        const int row0 = u.pm * BM + wr * 64 + fr, col0 = u.pn * BM + wc * 32 + 4 * fq;
#pragma unroll
        for (int ai = 0; ai < 2; ++ai)
#pragma unroll
            for (int m = 0; m < 4; ++m) { const size_t off = (size_t)(row0 + ai * HALF + m * 16) * DM + col0;
#pragma unroll
                for (int bj = 0; bj < 2; ++bj)
#pragma unroll
                    for (int n = 0; n < 2; ++n) { const size_t o = off + bj * HALF + n * 16; const u32x2 pw = *(const u32x2*)(pp + o); const f32x4 a = acc[ai][bj][m][n]; f32x4 r = *(const f32x4*)(x2 + o);
                        r[0] += fast_sigmoid(a[0]) * __builtin_bit_cast(float, pw.x << 16); r[1] += fast_sigmoid(a[1]) * __builtin_bit_cast(float, pw.x & 0xffff0000u);
                        r[2] += fast_sigmoid(a[2]) * __builtin_bit_cast(float, pw.y << 16); r[3] += fast_sigmoid(a[3]) * __builtin_bit_cast(float, pw.y & 0xffff0000u);
                        *(f32x4*)(out + o) = r; } }
    }
};

constexpr int MOE_MAXU = 24;
struct MoeRec { int e, mt, pn, nvalid, arow0, pad0, pad1, pad2; };
struct MoeOrder {
    LAS const int* tab;
    unsigned bstride_e, btile;
    int a_dense, wave;
    __device__ __forceinline__ bool next(int i, Unit& u) const {
        const int n = __builtin_amdgcn_readfirstlane(tab[0]); if (i >= n) return false;
        LAS const int* r = tab + 16 + i * 8;
        u.e = __builtin_amdgcn_readfirstlane(r[0]); u.pm = __builtin_amdgcn_readfirstlane(r[1]); u.pn = __builtin_amdgcn_readfirstlane(r[2]); u.nvalid = __builtin_amdgcn_readfirstlane(r[3]);
        const int arow0 = __builtin_amdgcn_readfirstlane(r[4]);
        u.aoff = a_dense ? (unsigned)arow0 * 1024u : 0u; u.boff = (unsigned)u.e * bstride_e + (unsigned)u.pn * btile; u.slot = i; u.keep = arow0; return true;
    }
    __device__ __forceinline__ void gather(const Unit& u, unsigned (&voffA)[2][2]) const {
        LAS const unsigned* g = (LAS const unsigned*)(tab + 256) + u.slot * 256;
        const int tid_ = wave * 64 + lane_id();
#pragma unroll
        for (int i = 0; i < 2; ++i) { int R, C; stage_rc(tid_ * 16 + i * 8192, R, C); voffA[0][i] = g[R] + (unsigned)C * 2u; voffA[1][i] = g[R + 128] + (unsigned)C * 2u; }
    }
};
__device__ __forceinline__ unsigned pk4_fp8(float a, float b, float c, float d) { int p = __builtin_amdgcn_cvt_pk_fp8_f32(a, b, 0, false); p = __builtin_amdgcn_cvt_pk_fp8_f32(c, d, p, true); return (unsigned)p; }
constexpr float W8_SCALE = 32.0f, W8_INV = 0.03125f;
struct EpiMoeGU {
    static constexpr bool PERM = true;
    const float* bias; unsigned char* act;
    __device__ __forceinline__ void operator()(Acc& acc, const Unit& u, int wr, int wc, int fr, int fq) const {
        { const int l_ = lane_id(); fr = l_ & 15; fq = l_ >> 4; }
        const int g0 = u.pn * 128 + wc * 32 + 8 * fq; const float* bg = bias + (size_t)u.e * 2048 + g0;
        const f32x4 bg0 = *(const f32x4*)bg, bg1 = *(const f32x4*)(bg + 4), bu0 = *(const f32x4*)(bg + 1024), bu1 = *(const f32x4*)(bg + 1028);
#pragma unroll
        for (int ai = 0; ai < 2; ++ai)
#pragma unroll
            for (int m = 0; m < 4; ++m) { const int r = ai * HALF + wr * 64 + m * 16 + fr;
                const f32x4 ga = acc[ai][0][m][0] * W8_INV + bg0, gb = acc[ai][0][m][1] * W8_INV + bg1, ua = acc[ai][1][m][0] * W8_INV + bu0, ub = acc[ai][1][m][1] * W8_INV + bu1; float o[8];
#pragma unroll
                for (int i = 0; i < 4; ++i) { const float g1 = fminf(ga[i], SW_LIMIT), g2 = fminf(gb[i], SW_LIMIT); const float u1 = fminf(fmaxf(ua[i], -SW_LIMIT), SW_LIMIT), u2 = fminf(fmaxf(ub[i], -SW_LIMIT), SW_LIMIT);
                    o[i] = (u1 + 1.0f) * (g1 * fast_sigmoid(g1 * SW_ALPHA)); o[4 + i] = (u2 + 1.0f) * (g2 * fast_sigmoid(g2 * SW_ALPHA)); }
                u32x2 w; w.x = pk4_fp8(o[0], o[1], o[2], o[3]); w.y = pk4_fp8(o[4], o[5], o[6], o[7]);
                if (r < u.nvalid) *(u32x2*)(act + (size_t)(u.keep + r) * DFF + g0) = w; }
    }
};
struct EpiMoeDown {
    static constexpr bool PERM = true;
    const float* bias; const int* rowlist; const float* roww; bf16* out4;
    __device__ __forceinline__ void operator()(Acc& acc, const Unit& u, int wr, int wc, int fr, int fq) const {
#pragma unroll
        for (int ai = 0; ai < 2; ++ai)
#pragma unroll
            for (int m = 0; m < 4; ++m) {
                asm volatile("" ::: "memory"); { const int l_ = lane_id(); fr = l_ & 15; fq = l_ >> 4; }
                const int c0 = u.pn * BM + wc * 32 + 8 * fq; const float* bp = bias + (size_t)u.e * DM + c0;
                const int r = ai * HALF + wr * 64 + m * 16 + fr; const bool ok = r < u.nvalid; const unsigned li = (unsigned)u.e * NT + (unsigned)u.pm * BM + (ok ? r : 0);
                const int ent = rowlist[li]; const float w = roww[li] * W8_INV; bf16* op = out4 + (size_t)ent * DM + c0;
#pragma unroll
                for (int bj = 0; bj < 2; ++bj) { const f32x4 b0 = *(const f32x4*)(bp + bj * HALF) * W8_SCALE, b1 = *(const f32x4*)(bp + bj * HALF + 4) * W8_SCALE;
                    const f32x4 v0 = (acc[ai][bj][m][0] + b0) * w, v1 = (acc[ai][bj][m][1] + b1) * w;
                    u32x4 o; o.x = cvt_pk_bf16(v0[0], v0[1]); o.y = cvt_pk_bf16(v0[2], v0[3]); o.z = cvt_pk_bf16(v1[0], v1[1]); o.w = cvt_pk_bf16(v1[2], v1[3]);
                    if (ok) *(u32x4*)(op + bj * HALF) = o; } }
    }
};
}

struct Frame {
    LAS unsigned char* lds; volatile LAS unsigned* MISC; gu32* ctl; int wave, vcu, G;
};
struct Args { const void* in[21]; float* out; unsigned char* ws; int ph_lo, ph_hi, li, pad; };

template <class RowFn>
__device__ __forceinline__ void p0_transpose_item(const float* W, int ldw, bf16* WT, int ldk, int koff, LAS float* scr, int kb, int nb, int lane, const RowFn& rowfn) {
    const int k0 = 64 * kb, n0 = 32 * nb;
    f32x4 v[8];
#pragma unroll
    for (int i = 0; i < 8; ++i) { const int kk = 8 * i + (lane >> 3); v[i] = *(const GAS f32x4*)(W + (size_t)(k0 + kk) * ldw + n0 + 4 * (lane & 7)); }
#pragma unroll
    for (int i = 0; i < 8; ++i) { const int kk = 8 * i + (lane >> 3); LAS float* d = scr + kk * 33 + 4 * (lane & 7); d[0] = v[i][0]; d[1] = v[i][1]; d[2] = v[i][2]; d[3] = v[i][3]; }
    LDS_WAIT(); asm volatile("" ::: "memory");
    const int c = lane & 7;
#pragma unroll
    for (int j = 0; j < 4; ++j) { const int n = (lane >> 3) + 8 * j; const LAS float* s = scr + (8 * c) * 33 + n;
        u32x4 o; o.x = pk2(s[0 * 33], s[1 * 33]); o.y = pk2(s[2 * 33], s[3 * 33]); o.z = pk2(s[4 * 33], s[5 * 33]); o.w = pk2(s[6 * 33], s[7 * 33]);
        *(GAS u32x4*)(WT + (size_t)rowfn(n0 + n) * ldk + koff + k0 + 8 * c) = o; }
    LDS_WAIT(); asm volatile("" ::: "memory");
}
struct RowId { __device__ __forceinline__ int operator()(int n) const { return n; } };
struct RowWin {
    __device__ __forceinline__ int operator()(int n) const { const int seg = n >> 10; if (seg >= 2) return n; const int c = n & 1023, head = c >> 7, d = c & 127;
        return seg * 1024 + (head >> 1) * 256 + ((d >> 6) << 7) + ((head & 1) << 6) + (d & 63); } };
struct RowWgu {
    __device__ __forceinline__ int operator()(int n) const { const int up = n >> 10, c = n & 1023; return (c >> 7) * 256 + up * 128 + (c & 127); } };

struct TDesc { const float* src; bf16* dst; int ldw, ldk, kind, n0, k0, f8; };
__device__ __forceinline__ bool p0_desc(int it, const Args& a, TDesc& d) {
    constexpr int I_IN = 16 * (INW / 32), I_SQ = 16 * 32, I_PP = 4 * 32, I_GU = 16 * 64, I_DN = 16 * 32;
    constexpr int NITEMS = I_IN + 3 * I_SQ + I_PP + NE * (I_GU + I_DN);
    if (it >= NITEMS) return false;
    unsigned char* ws = a.ws; int r = it; int nbw; d.kind = 0; d.f8 = 0;
    if (r < I_IN) { d.src = (const float*)a.in[4]; d.ldw = INW; d.dst = (bf16*)(ws + WS_WIN); d.ldk = DM; d.kind = 1; nbw = INW / 32; }
    else if ((r -= I_IN) < I_SQ) { d.src = (const float*)a.in[8]; d.ldw = DM; d.dst = (bf16*)(ws + WS_WB); d.ldk = 2048; nbw = 32; }
    else if ((r -= I_SQ) < I_SQ) { d.src = (const float*)a.in[9]; d.ldw = DM; d.dst = (bf16*)(ws + WS_WOUT); d.ldk = DM; nbw = 32; }
    else if ((r -= I_SQ) < I_SQ) { d.src = (const float*)a.in[18]; d.ldw = DM; d.dst = (bf16*)(ws + WS_WPG); d.ldk = DM; nbw = 32; }
    else if ((r -= I_SQ) < I_PP) { d.src = (const float*)a.in[19]; d.ldw = DM; d.dst = (bf16*)(ws + WS_WPP); d.ldk = PLE; nbw = 32; }
    else { r -= I_PP; const int e = r / (I_GU + I_DN); r -= e * (I_GU + I_DN);
        if (r < I_GU) { d.src = (const float*)a.in[13] + (size_t)e * DM * 2048; d.ldw = 2048; d.dst = (bf16*)(ws + WS_WGU + (size_t)e * 2048 * DM); d.ldk = DM; d.kind = 2; d.f8 = 1; nbw = 64; }
        else { r -= I_GU; d.src = (const float*)a.in[15] + (size_t)e * DFF * DM; d.ldw = DM; d.dst = (bf16*)(ws + WS_WD + (size_t)e * DM * DFF); d.ldk = DFF; d.f8 = 1; nbw = 32; } }
    d.k0 = 64 * (r / nbw); d.n0 = 32 * (r % nbw); return true;
}
__device__ __forceinline__ void p0_tload(const TDesc& d, int lane, f32x4 (&v)[8]) {
#pragma unroll
    for (int i = 0; i < 8; ++i) { const int kk = 8 * i + (lane >> 3); v[i] = *(const GAS f32x4*)(d.src + (size_t)(d.k0 + kk) * d.ldw + d.n0 + 4 * (lane & 7)); }
}
__device__ __forceinline__ void p0_tstore(const TDesc& d, int lane, LAS float* scr, const f32x4 (&v)[8]) {
#pragma unroll
    for (int i = 0; i < 8; ++i) { const int kk = 8 * i + (lane >> 3); LAS float* q = scr + kk * 33 + 4 * (lane & 7); q[0] = v[i][0]; q[1] = v[i][1]; q[2] = v[i][2]; q[3] = v[i][3]; }
    LDS_WAIT(); asm volatile("" ::: "memory");
    if (d.f8) {
        const int n = lane >> 1, kh = lane & 1; const LAS float* sp = scr + (32 * kh) * 33 + n; unsigned w[8];
#pragma unroll
        for (int q = 0; q < 8; ++q) w[q] = pg8::pk4_fp8(sp[(4 * q) * 33] * pg8::W8_SCALE, sp[(4 * q + 1) * 33] * pg8::W8_SCALE, sp[(4 * q + 2) * 33] * pg8::W8_SCALE, sp[(4 * q + 3) * 33] * pg8::W8_SCALE);
        const int nn = d.n0 + n; const int row = d.kind == 2 ? RowWgu()(nn) : nn;
        GAS u32x4* o = (GAS u32x4*)((unsigned char*)d.dst + (size_t)row * d.ldk + d.k0 + 32 * kh);
        o[0] = (u32x4){w[0], w[1], w[2], w[3]}; o[1] = (u32x4){w[4], w[5], w[6], w[7]};
        LDS_WAIT(); asm volatile("" ::: "memory"); return; }
    const int c = lane & 7;
#pragma unroll
    for (int j = 0; j < 4; ++j) { const int n = (lane >> 3) + 8 * j; const LAS float* sp = scr + (8 * c) * 33 + n;
        u32x4 o; o.x = pk2(sp[0 * 33], sp[1 * 33]); o.y = pk2(sp[2 * 33], sp[3 * 33]); o.z = pk2(sp[4 * 33], sp[5 * 33]); o.w = pk2(sp[6 * 33], sp[7 * 33]);
        const int nn = d.n0 + n; const int row = d.kind == 1 ? RowWin()(nn) : (d.kind == 2 ? RowWgu()(nn) : nn);
        *(GAS u32x4*)(d.dst + (size_t)row * d.ldk + d.k0 + 8 * c) = o; }
    LDS_WAIT(); asm volatile("" ::: "memory");
}

__device__ __forceinline__ void p0_prologue(Frame& F, const Args& a) {
    const int LANE_ = lane_id(); const int TID_ = F.wave * 64 + LANE_; (void)TID_;
    unsigned char* ws = a.ws;
    LAS float* scr = (LAS float*)(F.lds + RING_OFF + F.wave * 16384);
    const int gw = F.vcu * NWAVES + F.wave, NGW = F.G * NWAVES;
    const float* w_in = (const float*)a.in[4]; const float* w_branch = (const float*)a.in[8]; const float* w_out = (const float*)a.in[9];
    const float* w_gu = (const float*)a.in[13]; const float* w_down = (const float*)a.in[15]; const float* w_pg = (const float*)a.in[18]; const float* w_pp = (const float*)a.in[19];
    { TDesc dc, dn; f32x4 vc[8], vn[8];
      bool hc = p0_desc(gw, a, dc); if (hc) p0_tload(dc, LANE_, vc);
      for (int it = gw; hc; it += NGW) {
          const bool hn = p0_desc(it + NGW, a, dn); if (hn) p0_tload(dn, LANE_, vn);
          p0_tstore(dc, LANE_, scr, vc);
          dc = dn; hc = hn;
#pragma unroll
          for (int i = 0; i < 8; ++i) vc[i] = vn[i];
      } }
    { const float* x = (const float*)a.in[0]; const float* g = (const float*)a.in[3]; bf16* H = (bf16*)(ws + WS_H);
      f32x4 gv[4];
#pragma unroll
      for (int j = 0; j < 4; ++j) gv[j] = *(const GAS f32x4*)(g + 4 * LANE_ + 256 * j);
      for (int m = gw; m < NT; m += NGW) {
          const GAS f32x4* xr = (const GAS f32x4*)(x + (size_t)m * DM) + LANE_; f32x4 v[4]; float s = 0.f;
#pragma unroll
          for (int j = 0; j < 4; ++j) { v[j] = xr[64 * j]; s += (v[j].x * v[j].x + v[j].y * v[j].y) + (v[j].z * v[j].z + v[j].w * v[j].w); }
          const float rs = rsqrtf(wave_sum(s) * (1.0f / DM) + RMS_EPS);
          GAS u32x2* o8 = (GAS u32x2*)(H + (size_t)m * DM) + LANE_;
#pragma unroll
          for (int j = 0; j < 4; ++j) { u32x2 o; o.x = pk2(v[j].x * rs * gv[j].x, v[j].y * rs * gv[j].y); o.y = pk2(v[j].z * rs * gv[j].z, v[j].w * rs * gv[j].w); o8[64 * j] = o; }
      } }
    { const float* p = (const float*)a.in[1]; bf16* PB = (bf16*)(ws + WS_PB); const int gt = F.vcu * (NWAVES * 64) + TID_, NGT = F.G * NWAVES * 64;
      for (int i = gt; i < NT * PLE / 8; i += NGT) { const f32x4 a0 = *(const GAS f32x4*)(p + (size_t)i * 8), a1 = *(const GAS f32x4*)(p + (size_t)i * 8 + 4);
          u32x4 o; o.x = pk2(a0.x, a0.y); o.y = pk2(a0.z, a0.w); o.z = pk2(a1.x, a1.y); o.w = pk2(a1.z, a1.w); *(GAS u32x4*)(PB + (size_t)i * 8) = o; }
      const int* pos = (const int*)a.in[2]; float* trig = (float*)(ws + WS_TRIG);
      for (int i = gt; i < NT * 64; i += NGT) { float c, s; rot_cs(pos[i >> 6], i & 63, c, s); { typedef float f32x2_ __attribute__((ext_vector_type(2))); *(GAS f32x2_*)(trig + (size_t)i * 2) = (f32x2_){c, s}; } }
      { const float* gf = (const float*)a.in[10]; const float* wr = (const float*)a.in[11]; float* wrg = (float*)(ws + WS_WRG);
        for (int i = gt; i < DM * NE; i += NGT) wrg[i] = gf[i >> 5] * wr[i]; }
    }
    { const float* wp = (const float*)a.in[6]; const float* psc = (const float*)a.in[7]; const float* wb1 = w_branch + (size_t)DM * DM; bf16* WB = (bf16*)(ws + WS_WB);
      const int hh = LANE_ >> 5, l31 = LANE_ & 31;
      for (int tile = gw; tile < 4 * 8 * 32; tile += NGW) { const int g = tile >> 8, kb = (tile >> 5) & 7, nb = tile & 31;
          const float* ap = wb1 + (size_t)(g * 256 + hh) * DM + nb * 32 + l31;
          const float* bp = wp + ((size_t)g * 256 + kb * 32 + l31) * 256;
          const float* sp = psc + g * 256;
          f32x16 acc; for (int i = 0; i < 16; ++i) acc[i] = 0.f;
#pragma unroll 4
          for (int s4 = 0; s4 < 64; ++s4) { const f32x4 pv = *(const GAS f32x4*)(bp + 4 * s4), sv = *(const GAS f32x4*)(sp + 4 * s4);
              const float a0 = ap[(size_t)(4 * s4) * DM], a1 = ap[(size_t)(4 * s4 + 2) * DM];
              const float b0 = hh ? pv[1] * sv[1] : pv[0] * sv[0], b1 = hh ? pv[3] * sv[3] : pv[2] * sv[2];
              acc = __builtin_amdgcn_mfma_f32_32x32x2f32(a0, b0, acc, 0, 0, 0); acc = __builtin_amdgcn_mfma_f32_32x32x2f32(a1, b1, acc, 0, 0, 0); }
#pragma unroll
          for (int r = 0; r < 16; ++r) { const int n = nb * 32 + (r & 3) + 8 * (r >> 2) + 4 * hh; WB[(size_t)n * 2048 + 1024 + g * 256 + kb * 32 + l31] = (bf16)f2bf(acc[r]); } }
    }
}

__device__ __forceinline__ void moe_build(Frame& F, const unsigned* cnt, const int* rowlist, int ntn, bool gather) {
    const int LANE_ = lane_id(); const int TID_ = F.wave * 64 + LANE_; (void)TID_;
    LAS int* tab = (LAS int*)(F.lds + LDS_TAB_OFF);
    LAS int* tp = tab + 6400;
    if (TID_ < 64) {
        const int e = LANE_; const int c = e < NE ? (int)cnt[e] : 0; const int tl = (c + 255) >> 8; int it = tl, ic = c;
#pragma unroll
        for (int o = 1; o < 32; o <<= 1) { const int a = __shfl_up(it, o), b = __shfl_up(ic, o); if ((e & 31) >= o) { it += a; ic += b; } }
        if (e < NE) { tp[e + 1] = it; tp[40 + e + 1] = ic; if (e == 0) { tp[0] = 0; tp[40] = 0; } }
    }
    __syncthreads();
    const int total = tp[NE] * ntn;
    if (TID_ < pg8::MOE_MAXU) {
        const int L = TID_ * F.G + F.vcu;
        if (L < total) { const int tix = L / ntn, pn = L % ntn; int e = 0;
            for (int q = 0; q < NE; ++q) if (tp[q + 1] <= tix) e = q + 1;
            const int mt = tix - tp[e], c = tp[40 + e + 1] - tp[40 + e]; int nv = c - mt * 256; nv = nv > 256 ? 256 : nv;
            LAS int* r = tab + 16 + TID_ * 8; r[0] = e; r[1] = mt; r[2] = pn; r[3] = nv; r[4] = tp[40 + e] + mt * 256; }
    }
    if (TID_ == 0) { int n = 0; while (n < pg8::MOE_MAXU && n * F.G + F.vcu < total) ++n; tab[0] = n; }
    __syncthreads();
    if (gather) { const int n = tab[0];
        for (int idx = TID_; idx < n * 256; idx += NWAVES * 64) { const int sl = idx >> 8, r = idx & 255; LAS const int* rec = tab + 16 + sl * 8; const int e = rec[0], mt = rec[1], nv = rec[3];
            const int rr = mt * 256 + (r < nv ? r : nv - 1); const int ent = rowlist[(size_t)e * NT + rr]; ((LAS unsigned*)(tab + 256))[idx] = (unsigned)(ent >> 2) * 1024u; } }
    __syncthreads();
}

__device__ __forceinline__ void ph_router(Frame& F, const Args& a) {
    const int LANE_ = lane_id(); const int TID_ = F.wave * 64 + LANE_; (void)TID_;
    unsigned char* ws = a.ws; const float* X1 = (const float*)(ws + WS_X1); bf16* H2 = (bf16*)(ws + WS_H2); const float* WRG = (const float*)(ws + WS_WRG);
    const float* gf = (const float*)a.in[10]; const float* br = (const float*)a.in[12];
    int* ROWLIST = (int*)(ws + WS_ROWLIST); float* ROWW = (float*)(ws + WS_ROWW); unsigned* CNT = (unsigned*)(ws + WS_CTL) + CW_CNT;
    LAS float* rstd = (LAS float*)(F.lds + RING_OFF); LAS float* part = (LAS float*)(F.lds + RING_OFF + 1024);
    LAS unsigned* cntl = (LAS unsigned*)(F.lds + RING_OFF + 1024 + 4 * 64 * 33 * 4); LAS unsigned* lbase = cntl + 32;
    f32x4 gv[4];
#pragma unroll
    for (int j = 0; j < 4; ++j) gv[j] = *(const GAS f32x4*)(gf + 4 * LANE_ + 256 * j);
    for (int tile = F.vcu; tile < NT / 64; tile += F.G) {
        const int t0 = tile * 64;
        for (int j = 0; j < 8; ++j) { const int tl = F.wave * 8 + j; const GAS f32x4* xr = (const GAS f32x4*)(X1 + (size_t)(t0 + tl) * DM) + LANE_; f32x4 v[4]; float sq = 0.f;
#pragma unroll
            for (int q = 0; q < 4; ++q) { v[q] = xr[64 * q]; sq += (v[q].x * v[q].x + v[q].y * v[q].y) + (v[q].z * v[q].z + v[q].w * v[q].w); }
            const float rs = rsqrtf(wave_sum(sq) * (1.0f / DM) + RMS_EPS); if (LANE_ == 0) rstd[tl] = rs;
            GAS unsigned* o4 = (GAS unsigned*)((unsigned char*)H2 + (size_t)(t0 + tl) * DM) + LANE_;
#pragma unroll
            for (int q = 0; q < 4; ++q) o4[64 * q] = pg8::pk4_fp8(v[q].x * rs * gv[q].x, v[q].y * rs * gv[q].y, v[q].z * rs * gv[q].z, v[q].w * rs * gv[q].w); }
        { const int th = F.wave & 1, kq = F.wave >> 1, hh = LANE_ >> 5, l31 = LANE_ & 31;
          const float* xa = X1 + (size_t)(t0 + 32 * th + l31) * DM + 256 * kq; const float* wb = WRG + (size_t)(256 * kq + hh) * NE + l31;
          f32x16 acc; for (int i = 0; i < 16; ++i) acc[i] = 0.f;
#pragma unroll 4
          for (int s4 = 0; s4 < 64; ++s4) { const f32x4 av = *(const GAS f32x4*)(xa + 4 * s4); const float b0 = wb[(4 * s4) * NE], b1 = wb[(4 * s4 + 2) * NE];
              const float a0 = hh ? av[1] : av[0], a1 = hh ? av[3] : av[2];
              acc = __builtin_amdgcn_mfma_f32_32x32x2f32(a0, b0, acc, 0, 0, 0); acc = __builtin_amdgcn_mfma_f32_32x32x2f32(a1, b1, acc, 0, 0, 0); }
#pragma unroll
          for (int r = 0; r < 16; ++r) { const int row = 32 * th + (r & 3) + 8 * (r >> 2) + 4 * hh; part[(kq * 64 + row) * 33 + l31] = acc[r]; } }
        if (TID_ < 32) cntl[TID_] = 0u;
        __syncthreads();
        if (F.wave == 0) { const int tl = LANE_; const float rs = rstd[tl];
            float v0 = -INFINITY, v1 = -INFINITY, v2 = -INFINITY, v3 = -INFINITY; int i0 = 0, i1 = 0, i2 = 0, i3 = 0;
#pragma unroll
            for (int e = 0; e < NE; ++e) { const float x = rs * ((part[(0 * 64 + tl) * 33 + e] + part[(1 * 64 + tl) * 33 + e]) + (part[(2 * 64 + tl) * 33 + e] + part[(3 * 64 + tl) * 33 + e])) + br[e];
                const bool c0 = x > v0, c1 = x > v1, c2 = x > v2, c3 = x > v3;
                v3 = c2 ? v2 : (c3 ? x : v3); i3 = c2 ? i2 : (c3 ? e : i3);
                v2 = c1 ? v1 : (c2 ? x : v2); i2 = c1 ? i1 : (c2 ? e : i2);
                v1 = c0 ? v0 : (c1 ? x : v1); i1 = c0 ? i0 : (c1 ? e : i1);
                v0 = c0 ? x : v0; i0 = c0 ? e : i0; }
            const float e1 = __expf(v1 - v0), e2 = __expf(v2 - v0), e3 = __expf(v3 - v0); const float inv = 1.0f / (1.0f + e1 + e2 + e3);
            const unsigned r0 = __hip_atomic_fetch_add(cntl + i0, 1u, __ATOMIC_RELAXED, __HIP_MEMORY_SCOPE_WORKGROUP), r1 = __hip_atomic_fetch_add(cntl + i1, 1u, __ATOMIC_RELAXED, __HIP_MEMORY_SCOPE_WORKGROUP);
            const unsigned r2 = __hip_atomic_fetch_add(cntl + i2, 1u, __ATOMIC_RELAXED, __HIP_MEMORY_SCOPE_WORKGROUP), r3 = __hip_atomic_fetch_add(cntl + i3, 1u, __ATOMIC_RELAXED, __HIP_MEMORY_SCOPE_WORKGROUP);
            LDS_WAIT(); asm volatile("" ::: "memory");
            if (LANE_ < 32) { const unsigned n = cntl[LANE_]; lbase[LANE_] = n ? __hip_atomic_fetch_add(CNT + LANE_, n, RLX_AGENT) : 0u; }
            LDS_WAIT(); asm volatile("" ::: "memory");
            const int ent = (t0 + tl) * 4;
            { const size_t q0 = (size_t)i0 * NT + lbase[i0] + r0, q1 = (size_t)i1 * NT + lbase[i1] + r1, q2 = (size_t)i2 * NT + lbase[i2] + r2, q3 = (size_t)i3 * NT + lbase[i3] + r3;
              ROWLIST[q0] = ent; ROWLIST[q1] = ent + 1; ROWLIST[q2] = ent + 2; ROWLIST[q3] = ent + 3; ROWW[q0] = inv; ROWW[q1] = e1 * inv; ROWW[q2] = e2 * inv; ROWW[q3] = e3 * inv; }
        }
        __syncthreads();
    }
}
typedef short s16x4 __attribute__((ext_vector_type(4)));
__device__ __forceinline__ s16x4 tr_read(LAS const unsigned char* p) { return __builtin_bit_cast(s16x4, __builtin_amdgcn_ds_read_tr16_b64_v4i16((LAS s16x4*)p)); }
__device__ __forceinline__ bf16x8 cat8(s16x4 lo, s16x4 hi) { return __builtin_shufflevector(lo, hi, 0, 1, 2, 3, 4, 5, 6, 7); }
__device__ __forceinline__ int crow(int reg, int h) { return (reg & 3) + 8 * (reg >> 2) + 4 * h; }
#define MFMA32(a, b, c) __builtin_amdgcn_mfma_f32_32x32x16_bf16((a), (b), (c), 0, 0, 0)
constexpr int KP = 272, VP = 320;
__device__ __forceinline__ float log2_gamma(int h) { return log1pf(-exp2f(-5.0f - (float)h)) * 1.4426950408889634f; }

template <int W> __device__ __forceinline__ void pool_run(unsigned char* ws, int it) {
    const bf16* U = (const bf16*)(ws + WS_U); bf16* YM = (bf16*)(ws + WS_YM);
    const int l = it & 63, g = (it >> 6) & 3, r2 = it >> 8;
    const int run = r2 * 2 + (l >> 5), c0 = (g * 32 + (l & 31)) * 8; const int t0 = run * 16, tt0 = t0 & (SEQ - 1);
    float sum[8];
#pragma unroll
    for (int i = 0; i < 8; ++i) sum[i] = 0.f;
    if (tt0 != 0) {
#pragma unroll
        for (int k = 1; k < W; ++k) { float f[8]; pg8::unpack8(*(const GAS u32x4*)(U + (size_t)(t0 - k) * DM + c0), f);
#pragma unroll
            for (int i = 0; i < 8; ++i) sum[i] += f[i]; } }
#pragma unroll
    for (int j = 0; j < 16; ++j) { const int t = t0 + j; float own[8]; pg8::unpack8(*(const GAS u32x4*)(U + (size_t)t * DM + c0), own);
#pragma unroll
        for (int i = 0; i < 8; ++i) sum[i] += own[i];
        if ((tt0 != 0 && j >= 1) || j >= W) { float f[8]; pg8::unpack8(*(const GAS u32x4*)(U + (size_t)(t - W) * DM + c0), f);
#pragma unroll
            for (int i = 0; i < 8; ++i) sum[i] -= f[i]; }
        const int cnt = (tt0 != 0 || j + 1 >= W) ? W : j + 1; const float ic = 1.0f / (float)cnt; u32x4 o;
        o.x = cvt_pk_bf16(sum[0] * ic - own[0], sum[1] * ic - own[1]); o.y = cvt_pk_bf16(sum[2] * ic - own[2], sum[3] * ic - own[3]);
        o.z = cvt_pk_bf16(sum[4] * ic - own[4], sum[5] * ic - own[5]); o.w = cvt_pk_bf16(sum[6] * ic - own[6], sum[7] * ic - own[7]);
        *(GAS u32x4*)(YM + (size_t)t * 2048 + 1024 + c0) = o; }
}
__device__ __forceinline__ void ph_kv_pool(Frame& F, const Args& a) {
    const int LANE_ = lane_id(); const int TID_ = F.wave * 64 + LANE_; (void)TID_;
    unsigned char* ws = a.ws; const bf16* K = (const bf16*)(ws + WS_K); const bf16* V = (const bf16*)(ws + WS_V); float* KVT = (float*)(ws + WS_KVT);
    LAS unsigned char* Ks = F.lds + RING_OFF; LAS unsigned char* Vs = F.lds + RING_OFF + 128 * VP;
    int lane = LANE_; asm volatile("" : "+v"(lane)); const int hh = lane >> 5, l31 = lane & 31, q4 = (lane & 15) >> 2, p4 = lane & 3, blk = (lane >> 4) & 1;
    for (int task = F.vcu; task < NB * NH * NCH; task += F.G) {
        const int bh = task >> 6, n = task & 63, b = bh >> 3, h = bh & 7; const float lg2 = log2_gamma(h);
        const size_t row0 = (size_t)b * SEQ + (size_t)n * CH; const int col0 = h * DH;
#pragma unroll
        for (int i = 0; i < 4; ++i) { const int idx = TID_ + 512 * i, r = idx >> 4, c = idx & 15;
            const u32x4 kv = *(const GAS u32x4*)(K + (row0 + r) * DM + col0 + c * 8); const u32x4 vv = *(const GAS u32x4*)(V + (row0 + r) * DM + col0 + c * 8);
            float f[8]; pg8::unpack8(vv, f); const float z = __builtin_amdgcn_exp2f(lg2 * (float)(CH - 1 - r));
            u32x4 vz; vz.x = cvt_pk_bf16(f[0] * z, f[1] * z); vz.y = cvt_pk_bf16(f[2] * z, f[3] * z); vz.z = cvt_pk_bf16(f[4] * z, f[5] * z); vz.w = cvt_pk_bf16(f[6] * z, f[7] * z);
            *(LAS u32x4*)(Ks + r * VP + c * 16) = kv; *(LAS u32x4*)(Vs + r * VP + c * 16) = vz; }
        __syncthreads();
        { const int eb = F.wave >> 1, db0 = 2 * (F.wave & 1);
          f32x16 acc0, acc1; for (int i = 0; i < 16; ++i) { acc0[i] = 0.f; acc1[i] = 0.f; }
#pragma unroll
          for (int s = 0; s < 8; ++s) { const int rb = (16 * s + 8 * hh + q4) * VP; const int cb = (16 * blk + 4 * p4) * 2;
              const bf16x8 af = cat8(tr_read(Vs + rb + eb * 64 + cb), tr_read(Vs + rb + 4 * VP + eb * 64 + cb));
              const bf16x8 b0 = cat8(tr_read(Ks + rb + db0 * 64 + cb), tr_read(Ks + rb + 4 * VP + db0 * 64 + cb));
              const bf16x8 b1 = cat8(tr_read(Ks + rb + (db0 + 1) * 64 + cb), tr_read(Ks + rb + 4 * VP + (db0 + 1) * 64 + cb));
              acc0 = MFMA32(af, b0, acc0); acc1 = MFMA32(af, b1, acc1); }
          float* o = KVT + ((size_t)bh * NCH + n) * DH * DH;
#pragma unroll
          for (int r = 0; r < 16; ++r) { const int e = eb * 32 + crow(r, hh); o[(size_t)e * DH + db0 * 32 + l31] = acc0[r]; o[(size_t)e * DH + (db0 + 1) * 32 + l31] = acc1[r]; } }
        __syncthreads();
    }
    { const int gt = F.vcu * (NWAVES * 64) + TID_, NGT = F.G * NWAVES * 64;
      for (int it = gt; it < NT * 128 / 16; it += NGT) { const int g = (it >> 6) & 3;
          if (g == 0) pool_run<2>(ws, it); else if (g == 1) pool_run<4>(ws, it); else if (g == 2) pool_run<8>(ws, it); else pool_run<16>(ws, it); } }
}
__device__ __forceinline__ void ph_scan(Frame& F, const Args& a) {
    const int LANE_ = lane_id(); const int TID_ = F.wave * 64 + LANE_; (void)TID_;
    unsigned char* ws = a.ws; const float* KVT = (const float*)(ws + WS_KVT); bf16* PREVT = (bf16*)(ws + WS_PREVT);
    const int gt = F.vcu * (NWAVES * 64) + TID_, NGT = F.G * NWAVES * 64;
    for (int idx = gt; idx < NB * NH * DH * DH / 2; idx += NGT) { const int bh = idx >> 13, ed = (idx & 8191) * 2; const float dec = __builtin_amdgcn_exp2f(log2_gamma(bh & 7) * (float)CH);
        float s0 = 0.f, s1 = 0.f; const size_t base = (size_t)bh * NCH * DH * DH + ed;
#pragma unroll 8
        for (int n = 0; n < NCH; ++n) { const size_t o = base + (size_t)n * DH * DH; const f32x2_t kv = *(const GAS f32x2_t*)(KVT + o);
            *(GAS unsigned*)(PREVT + o) = cvt_pk_bf16(s0, s1); s0 = s0 * dec + kv.x; s1 = s1 * dec + kv.y; } }
}
#define DPP_ADD(v, ctrl) ((v) + __builtin_bit_cast(float, __builtin_amdgcn_update_dpp(0, __builtin_bit_cast(int, (v)), (ctrl), 0xf, 0xf, true)))
__device__ __forceinline__ float red32(float v) { v = DPP_ADD(v, 0xB1); v = DPP_ADD(v, 0x4E); v = DPP_ADD(v, 0x124); v = DPP_ADD(v, 0x128); return v + __shfl_xor(v, 16); }
#define RAW_BAR() asm volatile("s_waitcnt lgkmcnt(0)\n\ts_barrier" ::: "memory")
__device__ __forceinline__ void ph_retout(Frame& F, const Args& a) {
    const int LANE_ = lane_id(); const int TID_ = F.wave * 64 + LANE_; (void)TID_;
    unsigned char* ws = a.ws; const bf16* Q = (const bf16*)(ws + WS_Q); const bf16* K = (const bf16*)(ws + WS_K); const bf16* V = (const bf16*)(ws + WS_V);
    const bf16* PREVT = (const bf16*)(ws + WS_PREVT); const bf16* SG = (const bf16*)(ws + WS_SG); const float* gn = (const float*)a.in[5]; bf16* YM = (bf16*)(ws + WS_YM);
    LAS unsigned char* Ks = F.lds + RING_OFF; LAS unsigned char* Vs = Ks + 128 * KP; LAS unsigned char* Qs = Vs + 128 * VP; LAS float* stat = (LAS float*)(Qs + 36864);
    LAS unsigned char* stg = Ks + F.wave * (32 * 144);
    const int ib = F.wave & 3, eh = F.wave >> 2, e0 = eh * 64;
    int tid = TID_; asm volatile("" : "+v"(tid));
    u32x4 kr[4], vr[4], qr[4];
#define RO_LOAD(task_) do { const int bh_ = (task_) >> 6, n_ = (task_) & 63; const size_t r0_ = (size_t)(bh_ >> 3) * SEQ + (size_t)n_ * CH; const int c0_ = (bh_ & 7) * DH; \
        _Pragma("unroll") for (int i = 0; i < 4; ++i) { const int idx = tid + 512 * i, r = idx >> 4, c = idx & 15; const size_t o_ = (r0_ + r) * DM + c0_ + c * 8; \
            kr[i] = *(const GAS u32x4*)(K + o_); vr[i] = *(const GAS u32x4*)(V + o_); qr[i] = *(const GAS u32x4*)(Q + o_); } } while (0)
    int task = F.vcu;
    if (task < NB * NH * NCH) RO_LOAD(task);
    for (; task < NB * NH * NCH; task += F.G) {
        const int bh = task >> 6, n = task & 63, b = bh >> 3, h = bh & 7; const float lg2 = log2_gamma(h);
        const size_t row0 = (size_t)b * SEQ + (size_t)n * CH; const int col0 = h * DH;
        asm volatile("" : "+v"(tid));
        const int lane = tid & 63, hh = lane >> 5, l31 = lane & 31, q4 = (lane & 15) >> 2, p4 = lane & 3, blk = (lane >> 4) & 1;
#pragma unroll
        for (int i = 0; i < 4; ++i) { const int idx = tid + 512 * i, r = idx >> 4, c = idx & 15;
            *(LAS u32x4*)(Ks + r * KP + c * 16) = kr[i]; *(LAS u32x4*)(Vs + r * VP + c * 16) = vr[i]; *(LAS u32x4*)(Qs + r * KP + c * 16) = qr[i]; }
        RAW_BAR();
        const LAS unsigned char* qp = Qs + (ib * 32 + l31) * KP + 16 * hh;
        bf16x8 pb0[8], pb1[8];
        { const bf16* pt = PREVT + (((size_t)bh * NCH + n) * DH + e0 + l31) * DH + 8 * hh;
#pragma unroll
          for (int s = 0; s < 8; ++s) { pb0[s] = *(const GAS bf16x8*)(pt + 16 * s); pb1[s] = *(const GAS bf16x8*)(pt + 32 * DH + 16 * s); } }
        __builtin_amdgcn_sched_barrier(0);
        f32x16 acc0, acc1; for (int i = 0; i < 16; ++i) { acc0[i] = 0.f; acc1[i] = 0.f; }
        for (int jb = 0; jb <= ib; ++jb) {
            f32x16 st; for (int i = 0; i < 16; ++i) st[i] = 0.f;
#pragma unroll
            for (int s = 0; s < 8; ++s) { const bf16x8 ka = *(const LAS bf16x8*)(Ks + (jb * 32 + l31) * KP + (16 * s + 8 * hh) * 2); st = MFMA32(ka, *(const LAS bf16x8*)(qp + 32 * s), st); }
#pragma unroll
            for (int r = 0; r < 16; ++r) { const int dl = (ib - jb) * 32 + l31 - crow(r, hh); st[r] = dl >= 0 ? st[r] * __builtin_amdgcn_exp2f(lg2 * (float)dl) : 0.f; }
#pragma unroll
            for (int s2 = 0; s2 < 2; ++s2) { u32x4 pw; pw.x = cvt_pk_bf16(st[8 * s2], st[8 * s2 + 1]); pw.y = cvt_pk_bf16(st[8 * s2 + 2], st[8 * s2 + 3]); pw.z = cvt_pk_bf16(st[8 * s2 + 4], st[8 * s2 + 5]); pw.w = cvt_pk_bf16(st[8 * s2 + 6], st[8 * s2 + 7]);
                const bf16x8 pa = __builtin_bit_cast(bf16x8, pw); const int rb = (jb * 32 + 16 * s2 + 4 * hh + q4) * VP; const int cb = (e0 + 16 * blk + 4 * p4) * 2;
                const bf16x8 v0 = cat8(tr_read(Vs + rb + cb), tr_read(Vs + rb + 8 * VP + cb)); const bf16x8 v1 = cat8(tr_read(Vs + rb + cb + 64), tr_read(Vs + rb + 8 * VP + cb + 64));
                acc0 = MFMA32(pa, v0, acc0); acc1 = MFMA32(pa, v1, acc1); }
        }
        __builtin_amdgcn_sched_barrier(0);
        u32x4 sg[4];
#pragma unroll
        for (int i = 0; i < 4; ++i) { const int idx = lane + 64 * i, rr = idx >> 3, ch = idx & 7; sg[i] = *(const GAS u32x4*)(SG + (row0 + ib * 32 + rr) * DM + col0 + e0 + ch * 8); }
        { f32x16 c0, c1; for (int i = 0; i < 16; ++i) { c0[i] = 0.f; c1[i] = 0.f; }
#pragma unroll
          for (int s = 0; s < 8; ++s) { const bf16x8 qs = *(const LAS bf16x8*)(qp + 32 * s); c0 = MFMA32(qs, pb0[s], c0); c1 = MFMA32(qs, pb1[s], c1); }
#pragma unroll
          for (int r = 0; r < 16; ++r) { const float xi = __builtin_amdgcn_exp2f(lg2 * (float)(ib * 32 + crow(r, hh) + 1)); acc0[r] += xi * c0[r]; acc1[r] += xi * c1[r]; } }
        __builtin_amdgcn_sched_barrier(0);
        if (task + F.G < NB * NH * NCH) RO_LOAD(task + F.G);
        __builtin_amdgcn_sched_barrier(0);
        float mw[16], m2[16];
#pragma unroll
        for (int r = 0; r < 16; ++r) { const float sm = red32(acc0[r] + acc1[r]);
            mw[r] = sm * (1.0f / 64.0f); const float d0 = acc0[r] - mw[r], d1 = acc1[r] - mw[r]; const float qq = red32(d0 * d0 + d1 * d1);
            m2[r] = qq; if (l31 == 0) { LAS float* sp = stat + ((ib * 2 + eh) * 32 + crow(r, hh)) * 2; sp[0] = mw[r]; sp[1] = qq; } }
        RAW_BAR();
#pragma unroll
        for (int r = 0; r < 16; ++r) { const LAS float* sp = stat + ((ib * 2 + (eh ^ 1)) * 32 + crow(r, hh)) * 2; const float mo = sp[0], qo = sp[1];
            const float mean = 0.5f * (mw[r] + mo), dm = mw[r] - mo; const float var = (m2[r] + qo + 32.0f * dm * dm) * (1.0f / 128.0f); const float rs = rsqrtf(var + GN_EPS);
            const float y0 = (acc0[r] - mean) * rs, y1 = (acc1[r] - mean) * rs;
            *(LAS unsigned short*)(stg + crow(r, hh) * 144 + l31 * 2) = (unsigned short)(cvt_pk_bf16(y0, 0.f) & 0xffffu); *(LAS unsigned short*)(stg + crow(r, hh) * 144 + (32 + l31) * 2) = (unsigned short)(cvt_pk_bf16(y1, 0.f) & 0xffffu); }
        LDS_WAIT(); asm volatile("" ::: "memory");
#pragma unroll
        for (int i = 0; i < 4; ++i) { const int idx = lane + 64 * i, rr = idx >> 3, ch = idx & 7; float y[8], g[8];
            pg8::unpack8(*(const LAS u32x4*)(stg + rr * 144 + ch * 16), y); const size_t t = row0 + ib * 32 + rr; const int cc = col0 + e0 + ch * 8;
            pg8::unpack8(sg[i], g); const f32x4 n0 = *(const GAS f32x4*)(gn + cc), n1 = *(const GAS f32x4*)(gn + cc + 4);
            u32x4 o; o.x = cvt_pk_bf16(y[0] * n0[0] * g[0], y[1] * n0[1] * g[1]); o.y = cvt_pk_bf16(y[2] * n0[2] * g[2], y[3] * n0[3] * g[3]);
            o.z = cvt_pk_bf16(y[4] * n1[0] * g[4], y[5] * n1[1] * g[5]); o.w = cvt_pk_bf16(y[6] * n1[2] * g[6], y[7] * n1[3] * g[7]);
            *(GAS u32x4*)(YM + t * 2048 + cc) = o; }
        RAW_BAR();
    }
#undef RO_LOAD
}

__device__ __forceinline__ void ph_combine(Frame& F, const Args& a) {
    const int LANE_ = lane_id(); const int TID_ = F.wave * 64 + LANE_; (void)TID_;
    unsigned char* ws = a.ws; const float* X1 = (const float*)(ws + WS_X1); const bf16* OUT4 = (const bf16*)(ws + WS_OUT4); float* X2 = (float*)(ws + WS_X2); bf16* H3 = (bf16*)(ws + WS_H3);
    const float* g = (const float*)a.in[17]; const int gw = F.vcu * NWAVES + F.wave, NGW = F.G * NWAVES;
    f32x4 gv[4];
#pragma unroll
    for (int j = 0; j < 4; ++j) gv[j] = *(const GAS f32x4*)(g + 4 * LANE_ + 256 * j);
    for (int m = gw; m < NT; m += NGW) {
        const GAS f32x4* xr = (const GAS f32x4*)(X1 + (size_t)m * DM) + LANE_; f32x4 v[4]; float sq = 0.f;
#pragma unroll
        for (int j = 0; j < 4; ++j) v[j] = xr[64 * j];
#pragma unroll
        for (int k = 0; k < 4; ++k) { const GAS u32x2* orow = (const GAS u32x2*)(OUT4 + ((size_t)m * 4 + k) * DM) + LANE_;
#pragma unroll
            for (int j = 0; j < 4; ++j) { const u32x2 w = orow[64 * j]; v[j].x += __builtin_bit_cast(float, w.x << 16); v[j].y += __builtin_bit_cast(float, w.x & 0xffff0000u); v[j].z += __builtin_bit_cast(float, w.y << 16); v[j].w += __builtin_bit_cast(float, w.y & 0xffff0000u); } }
        GAS f32x4* x2r = (GAS f32x4*)(X2 + (size_t)m * DM) + LANE_;
#pragma unroll
        for (int j = 0; j < 4; ++j) { x2r[64 * j] = v[j]; sq += (v[j].x * v[j].x + v[j].y * v[j].y) + (v[j].z * v[j].z + v[j].w * v[j].w); }
        const float rs = rsqrtf(wave_sum(sq) * (1.0f / DM) + RMS_EPS);
        GAS u32x2* o8 = (GAS u32x2*)(H3 + (size_t)m * DM) + LANE_;
#pragma unroll
        for (int j = 0; j < 4; ++j) { u32x2 o; o.x = pk2(v[j].x * rs * gv[j].x, v[j].y * rs * gv[j].y); o.y = pk2(v[j].z * rs * gv[j].z, v[j].w * rs * gv[j].w); o8[64 * j] = o; }
    }
}
__device__ __forceinline__ void ph_final(Frame& F, const Args& a) {
    const int LANE_ = lane_id(); const int TID_ = F.wave * 64 + LANE_; (void)TID_;
    const float* g = (const float*)a.in[20]; const int gw = F.vcu * NWAVES + F.wave, NGW = F.G * NWAVES;
    f32x4 gv[4];
#pragma unroll
    for (int j = 0; j < 4; ++j) gv[j] = *(const GAS f32x4*)(g + 4 * LANE_ + 256 * j);
    for (int m = gw; m < NT; m += NGW) {
        GAS f32x4* xr = (GAS f32x4*)(a.out + (size_t)m * DM) + LANE_; f32x4 v[4]; float sq = 0.f;
#pragma unroll
        for (int j = 0; j < 4; ++j) { v[j] = xr[64 * j]; sq += (v[j].x * v[j].x + v[j].y * v[j].y) + (v[j].z * v[j].z + v[j].w * v[j].w); }
        const float rs = rsqrtf(wave_sum(sq) * (1.0f / DM) + RMS_EPS);
#pragma unroll
        for (int j = 0; j < 4; ++j) xr[64 * j] = v[j] * rs * gv[j];
    }
}

__global__ void __launch_bounds__(NWAVES * 64, 2) fused_fwd(Args args) {
    extern __shared__ __attribute__((aligned(16))) unsigned char lds[];
    Frame F;
    F.lds = (LAS unsigned char*)lds; F.MISC = (volatile LAS unsigned*)(F.lds + MISC_OFF);
    F.wave = __builtin_amdgcn_readfirstlane((int)threadIdx.x >> 6);
    F.G = gridDim.x; { const int bx = blockIdx.x; F.vcu = (F.G % 8 == 0) ? (bx % 8) * (F.G / 8) + bx / 8 : bx; }
    unsigned char* ws = args.ws;
    F.ctl = (gu32*)(ws + WS_CTL);
    { const int u = F.wave * 64 + lane_id(); if (u < 256) ((LAS unsigned*)(F.lds + LDSCTL_OFF))[u] = 0u; }
    __syncthreads();
    XcdBarrier bar = xcd_barrier_post((unsigned*)(F.ctl + CW_BAR) + args.li * XCD_BAR_WORDS, F.MISC + 8, F.wave);
    const int lo = args.ph_lo, hi = args.ph_hi;
#ifndef PHMASK
#define PHMASK 0x1fff
#endif
#define IN(k) (((PHMASK >> (k)) & 1) && lo <= (k) && (k) < hi)
#define STAMP(k) do {} while (0)
#define SEAM(k) do { if (IN(k) && IN((k) + 1)) xcd_barrier(bar); } while (0)
#define NREP(k) (((k) >= REP_LO && (k) < REP_HI) ? 2 : 1)
    for (int rep_ = 0; rep_ < NREP(0); ++rep_) if (IN(0) && (rep_ == 0 || (xcd_barrier(bar), true))) { p0_prologue(F, args); }
    SEAM(0);
    for (int rep_ = 0; rep_ < NREP(1); ++rep_) if (IN(1) && (rep_ == 0 || (xcd_barrier(bar), true))) {
        { pg8::StaticOrder S; S.init(NT, INW, DM, F.G, (int)blockIdx.x);
          pg8::EpiIn E{(bf16*)(ws + WS_Q), (const float*)(ws + WS_TRIG)};
          pg8::gemm_phase<pg8::EpiIn, pg8::StaticOrder, true, false>(F.lds + RING_OFF, DM, DM, DM, (const char*)(ws + WS_H), (const char*)(ws + WS_WIN), S, E, F.wave); }
        { pg8::StaticOrder S; S.init(NT, DM, PLE, F.G, (int)blockIdx.x);
          pg8::EpiPlainBf16 E{(bf16*)(ws + WS_PP), DM, 0};
          pg8::gemm_phase<pg8::EpiPlainBf16, pg8::StaticOrder, false, false>(F.lds + RING_OFF, PLE, PLE, PLE, (const char*)(ws + WS_PB), (const char*)(ws + WS_WPP), S, E, F.wave); }
    }
    SEAM(1);
    for (int rep_ = 0; rep_ < NREP(2); ++rep_) if (IN(2) && (rep_ == 0 || (xcd_barrier(bar), true))) ph_kv_pool(F, args);
    SEAM(2);
    for (int rep_ = 0; rep_ < NREP(3); ++rep_) if (IN(3) && (rep_ == 0 || (xcd_barrier(bar), true))) ph_scan(F, args);
    SEAM(3);
    for (int rep_ = 0; rep_ < NREP(4); ++rep_) if (IN(4) && (rep_ == 0 || (xcd_barrier(bar), true))) ph_retout(F, args);
    SEAM(4);
#ifndef SKIP5
    for (int rep_ = 0; rep_ < NREP(5); ++rep_) if (IN(5) && (rep_ == 0 || (xcd_barrier(bar), true))) {
        pg8::TwoPartOrder S; S.base.init(NT, DM, DM, F.G, (int)blockIdx.x);
        pg8::EpiMerged E{(const bf16*)(ws + WS_GA), (const bf16*)(ws + WS_GB), (bf16*)(ws + WS_MERGED), (bf16*)(ws + WS_X2)};
        pg8::gemm_phase<pg8::EpiMerged, pg8::TwoPartOrder, false, false>(F.lds + RING_OFF, DM, 2048, 2048, (const char*)(ws + WS_YM), (const char*)(ws + WS_WB), S, E, F.wave);
    }
#endif
    SEAM(5);
#ifndef SKIP6
    for (int rep_ = 0; rep_ < NREP(6); ++rep_) if (IN(6) && (rep_ == 0 || (xcd_barrier(bar), true))) {
        pg8::StaticOrder S; S.init(NT, DM, DM, F.G, (int)blockIdx.x);
        pg8::EpiResidF32 E{(const float*)args.in[0], (float*)(ws + WS_X1)};
        pg8::gemm_phase<pg8::EpiResidF32, pg8::StaticOrder, false, false>(F.lds + RING_OFF, DM, DM, DM, (const char*)(ws + WS_MERGED), (const char*)(ws + WS_WOUT), S, E, F.wave);
    }
#endif
    SEAM(6);
    for (int rep_ = 0; rep_ < NREP(7); ++rep_) if (IN(7) && (rep_ == 0 || (xcd_barrier(bar), true))) ph_router(F, args);
    SEAM(7);
    for (int rep_ = 0; rep_ < NREP(8); ++rep_) if (IN(8) && (rep_ == 0 || (xcd_barrier(bar), true))) {
        const unsigned* CNT = (const unsigned*)(ws + WS_CTL) + CW_CNT;
        moe_build(F, CNT, (const int*)(ws + WS_ROWLIST), 8, true);
        pg8::MoeOrder S{(LAS const int*)(F.lds + LDS_TAB_OFF), 2048u * 1024u, 256u * 1024u, 0, F.wave};
        pg8::EpiMoeGU E{(const float*)args.in[14], (unsigned char*)(ws + WS_ACT)};
        pg8::gemm_phase<pg8::EpiMoeGU, pg8::MoeOrder, true, true, true>(F.lds + RING_OFF, DM, DM, DM, (const char*)(ws + WS_H2), (const char*)(ws + WS_WGU), S, E, F.wave);
    }
    SEAM(8);
    for (int rep_ = 0; rep_ < NREP(9); ++rep_) if (IN(9) && (rep_ == 0 || (xcd_barrier(bar), true))) {
        const unsigned* CNT = (const unsigned*)(ws + WS_CTL) + CW_CNT;
        moe_build(F, CNT, (const int*)(ws + WS_ROWLIST), 4, false);
        pg8::MoeOrder S{(LAS const int*)(F.lds + LDS_TAB_OFF), 1024u * 1024u, 256u * 1024u, 1, F.wave};
        pg8::EpiMoeDown E{(const float*)args.in[16], (const int*)(ws + WS_ROWLIST), (const float*)(ws + WS_ROWW), (bf16*)(ws + WS_OUT4)};
        pg8::gemm_phase<pg8::EpiMoeDown, pg8::MoeOrder, true, false, true>(F.lds + RING_OFF, DFF, DFF, DFF, (const char*)(ws + WS_ACT), (const char*)(ws + WS_WD), S, E, F.wave);
    }
    SEAM(9);
    for (int rep_ = 0; rep_ < NREP(10); ++rep_) if (IN(10) && (rep_ == 0 || (xcd_barrier(bar), true))) ph_combine(F, args);
    SEAM(10);
#ifndef SKIP11
    for (int rep_ = 0; rep_ < NREP(11); ++rep_) if (IN(11) && (rep_ == 0 || (xcd_barrier(bar), true))) {
        pg8::StaticOrder S; S.init(NT, DM, DM, F.G, (int)blockIdx.x);
        pg8::EpiPleOut E{(const float*)(ws + WS_X2), (const bf16*)(ws + WS_PP), args.out};
        pg8::gemm_phase<pg8::EpiPleOut, pg8::StaticOrder, false, false>(F.lds + RING_OFF, DM, DM, DM, (const char*)(ws + WS_H3), (const char*)(ws + WS_WPG), S, E, F.wave);
    }
#endif
    SEAM(11);
    if (IN(12)) ph_final(F, args);
#undef IN
#undef SEAM
}

static int fused_grid() {
    static int grid = 0;
    if (grid == 0) {
        int dev = 0, cus = 0;
        if (hipGetDevice(&dev) != hipSuccess || hipDeviceGetAttribute(&cus, hipDeviceAttributeMultiprocessorCount, dev) != hipSuccess) { grid = -1; return grid; }
        if (hipFuncSetAttribute((const void*)fused_fwd, hipFuncAttributeMaxDynamicSharedMemorySize, LDS_BYTES) != hipSuccess) { fprintf(stderr, "hipFuncSetAttribute failed\n"); grid = -1; return grid; }
        (void)hipGetLastError();
        grid = cus;
    }
    return grid;
}
static void launch_fused(void* const* d_in, float* out, unsigned char* ws, int lo, int hi, int li, hipStream_t st) {
    const int grid = fused_grid(); if (grid <= 0) return;
    Args a; memset(&a, 0, sizeof(a));
    for (int i = 0; i < 21; ++i) a.in[i] = d_in[i];
    a.out = out; a.ws = ws; a.ph_lo = lo; a.ph_hi = hi; a.li = li;
    hipLaunchKernelGGL(fused_fwd, dim3(grid), dim3(NWAVES * 64), LDS_BYTES, st, a);
}

extern "C" void kernel_launch(void* const* d_in, const int* in_sizes, int n_in, void* d_out, int out_size, void* d_ws, size_t ws_size, hipStream_t stream) {
    if (n_in != 21 || out_size != NT * DM || ws_size < WS_END) { fprintf(stderr, "kernel_launch: unexpected shapes (n_in %d out %d ws %zu)\n", n_in, out_size, ws_size); return; }
    (void)in_sizes;
    (void)hipMemsetAsync((char*)d_ws + WS_CTL, 0, CTL_ZERO_BYTES, stream);
#if MK_NAIVE == 2
    naive_forward(d_in, (float*)d_out, (unsigned char*)d_ws, stream, ~0u);
#else
    launch_fused(d_in, (float*)d_out, (unsigned char*)d_ws, 0, 13, 0, stream);
    if (EXTRA_LO < EXTRA_HI) launch_fused(d_in, (float*)d_out, (unsigned char*)d_ws, EXTRA_LO, EXTRA_HI, 1, stream);
#endif
}
```
